# Optimizing an MI355X kernel written in HIP

```python
import math
import jax
import jax.numpy as jnp
from jax import lax
import numpy as np

D_MODEL = 2048
BATCH = 16
SEQ = 2048
DEPTH = 2

GRID_W = 64
D_HYENA = 1024
SHORT_CONV = 3
FILTER_EMB = 33
FILTER_HIDDEN = 64
DECAY_TARGET = 1e-2
FAST_DECAY_PCT = 0.3
SLOW_DECAY_PCT = 1.5
HEAD_DIM = 64
N_Q_HEADS = 16
N_KV_HEADS = 4
D_ATTN = N_Q_HEADS * HEAD_DIM
D_KV = N_KV_HEADS * HEAD_DIM
Q_BLOCK = 128
ROPE_THETA = 10000.0
N_BRANCH = 2
D_IN = 3 * D_HYENA + D_ATTN + 2 * D_KV + N_BRANCH * D_MODEL
D_FF = 5632
N_EXPERTS = 8
TOP_K = 2
D_FF_EXPERT = 7168
MOE_BLOCK = 1024
N_DENSE = (DEPTH + 1) // 2
N_MOE = DEPTH // 2
DEEPNORM_ALPHA = (2 * DEPTH) ** 0.25
DEEPNORM_BETA = (8 * DEPTH) ** -0.25
LN_EPS = 1e-5
RMS_EPS = 1e-6

F32 = jnp.float32

kernel_name = 'hybrid_hyena_gqa_moe_encoder'


def layer_norm(x, g, b):
    xf = x.astype(F32)
    mu = jnp.mean(xf, axis=-1, keepdims=True)
    xc = xf - mu
    var = jnp.mean(xc * xc, axis=-1, keepdims=True)
    return (xc * lax.rsqrt(var + LN_EPS) * g.astype(F32) + b.astype(F32)).astype(x.dtype)


def rms_norm(x, g):
    xf = x.astype(F32)
    return (xf * lax.rsqrt(jnp.mean(xf * xf, axis=-1, keepdims=True) + RMS_EPS) * g.astype(F32)).astype(x.dtype)


def centred_short_conv(u, w, b):
    L = u.shape[1]
    p = SHORT_CONV // 2
    up = jnp.pad(u, ((0, 0), (p, SHORT_CONV - 1 - p), (0, 0)))
    return sum(up[:, j:j + L] * w[j] for j in range(SHORT_CONV)) + b


def hyena_filters(L, fw1, fb1, fw2, fb2, fw3, freq):
    t = jnp.linspace(0.0, 1.0, L, dtype=F32)[:, None]
    bands = (FILTER_EMB - 1) // 2
    w = 2.0 * math.pi * jnp.arange(L, dtype=F32)[:, None] / L
    f = jnp.linspace(1e-4, bands - 1, bands, dtype=F32)[None, :]
    z = jnp.concatenate([t, jnp.cos(f * w), -jnp.sin(f * w)], axis=-1)
    fr = freq.astype(F32)
    a = jnp.sin(fr[0] * (z @ fw1.astype(F32) + fb1.astype(F32)))
    a = jnp.sin(fr[1] * (a @ fw2.astype(F32) + fb2.astype(F32)))
    hk = a @ fw3.astype(F32)
    min_decay = math.log(DECAY_TARGET) / SLOW_DECAY_PCT
    max_decay = math.log(DECAY_TARGET) / FAST_DECAY_PCT
    deltas = jnp.abs(jnp.linspace(min_decay, max_decay, D_HYENA, dtype=F32))
    window = jnp.exp(-t * deltas[None, :])
    return hk[:, :D_HYENA] * window, hk[:, D_HYENA:] * window


def bidir_long_conv(v, h_fwd, h_bwd, bias):
    B, L, C = v.shape
    k = jnp.concatenate([h_fwd, jnp.zeros((1, C), F32), h_bwd[:0:-1]], axis=0)
    k_f = jnp.fft.rfft(k, n=2 * L, axis=0)
    vf = v.astype(F32)
    v_f = jnp.fft.rfft(vf, n=2 * L, axis=1)
    y = jnp.fft.irfft(v_f * k_f[None], n=2 * L, axis=1)[:, :L]
    return (y + vf * bias.astype(F32)).astype(v.dtype)


def axial_rope(L):
    rows = L // GRID_W
    row = jnp.repeat(jnp.arange(rows, dtype=F32), GRID_W)
    col = jnp.tile(jnp.arange(GRID_W, dtype=F32), rows)
    n_pairs = HEAD_DIM // 4
    inv = ROPE_THETA ** (-jnp.arange(n_pairs, dtype=F32) / n_pairs)
    ang = jnp.concatenate([row[:, None] * inv, col[:, None] * inv], axis=-1)
    return jnp.cos(ang), jnp.sin(ang)


def apply_rope(x, cos, sin):
    xf = x.astype(F32)
    half = HEAD_DIM // 2
    x1, x2 = xf[..., :half], xf[..., half:]
    c = cos[None, :, None, :]
    s = sin[None, :, None, :]
    return jnp.concatenate([x1 * c - x2 * s, x2 * c + x1 * s], axis=-1).astype(x.dtype)


def block_gqa(q, k, v):
    B, L = q.shape[:2]
    G = N_Q_HEADS // N_KV_HEADS
    nblk = L // Q_BLOCK
    qb = q.reshape(B, nblk, Q_BLOCK, N_KV_HEADS, G, HEAD_DIM).transpose(1, 0, 2, 3, 4, 5)
    scale = HEAD_DIM ** -0.5

    def attend(q_blk):
        s = jnp.einsum('bqkgd,bskd->bkgqs', q_blk, k).astype(F32) * scale
        p = jax.nn.softmax(s, axis=-1).astype(v.dtype)
        return jnp.einsum('bkgqs,bskd->bqkgd', p, v)

    o = lax.map(attend, qb)
    return o.transpose(1, 0, 2, 3, 4, 5).reshape(B, L, D_ATTN)


def hybrid_mixer(h, w_in, conv_w, conv_b, fw1, fb1, fw2, fb2, fw3, freq, hy_bias,
                 q_g, k_g, w_hy_br, w_att_br, w_o):
    B, L, _ = h.shape
    proj = h @ w_in
    o0 = 3 * D_HYENA
    o1 = o0 + D_ATTN
    o2 = o1 + D_KV
    o3 = o2 + D_KV
    u = centred_short_conv(proj[..., :o0], conv_w, conv_b)
    x0, x1, hv = jnp.split(u, 3, axis=-1)
    h_fwd, h_bwd = hyena_filters(L, fw1, fb1, fw2, fb2, fw3, freq)
    y_hy = x0 * bidir_long_conv(x1 * hv, h_fwd, h_bwd, hy_bias)
    cos, sin = axial_rope(L)
    q = apply_rope(rms_norm(proj[..., o0:o1].reshape(B, L, N_Q_HEADS, HEAD_DIM), q_g), cos, sin)
    k = apply_rope(rms_norm(proj[..., o1:o2].reshape(B, L, N_KV_HEADS, HEAD_DIM), k_g), cos, sin)
    v = proj[..., o2:o3].reshape(B, L, N_KV_HEADS, HEAD_DIM)
    y_att = block_gqa(q, k, v)
    gates = jax.nn.sigmoid(proj[..., o3:].astype(F32)).astype(h.dtype).reshape(B, L, N_BRANCH, D_MODEL)
    merged = gates[:, :, 0] * (y_hy @ w_hy_br) + gates[:, :, 1] * (y_att @ w_att_br)
    return merged @ w_o


def dense_swiglu(h, w_gate, w_up, w_down):
    return (jax.nn.silu(h @ w_gate) * (h @ w_up)) @ w_down


def moe_swiglu(h, router_w, router_b, w_gate, w_up, w_down):
    B, L, D = h.shape
    T = B * L
    xt = h.reshape(T, D)
    logits = (xt @ router_w).astype(F32) + router_b.astype(F32)
    top_logit, top_e = lax.top_k(logits, TOP_K)
    top_w = jax.nn.softmax(top_logit, axis=-1)
    A = T * TOP_K
    flat_e = top_e.reshape(A).astype(jnp.int32)
    flat_tok = jnp.arange(A, dtype=jnp.int32) // TOP_K
    flat_w = top_w.reshape(A)
    order = jnp.argsort(flat_e)
    se = flat_e[order]
    counts = jnp.zeros((N_EXPERTS,), jnp.int32).at[flat_e].add(1)
    padded = (counts + MOE_BLOCK - 1) // MOE_BLOCK * MOE_BLOCK
    pad_end = jnp.cumsum(padded)
    pad_start = pad_end - padded
    start = jnp.cumsum(counts) - counts
    dest = pad_start[se] + jnp.arange(A, dtype=jnp.int32) - start[se]
    nblk = -(-(A + N_EXPERTS * (MOE_BLOCK - 1)) // MOE_BLOCK)
    P = nblk * MOE_BLOCK
    src_tok = jnp.zeros((P,), jnp.int32).at[dest].set(flat_tok[order])
    src_w = jnp.zeros((P,), F32).at[dest].set(flat_w[order])
    blk_e = jnp.minimum(jnp.searchsorted(pad_end, jnp.arange(nblk, dtype=jnp.int32) * MOE_BLOCK, side='right'),
                        N_EXPERTS - 1)
    xb = xt[src_tok].reshape(nblk, MOE_BLOCK, D)

    def expert_block(args):
        x_blk, e = args
        return (jax.nn.silu(x_blk @ w_gate[e]) * (x_blk @ w_up[e])) @ w_down[e]

    yb = lax.map(expert_block, (xb, blk_e)).reshape(P, D)
    out = jnp.zeros((T, D), h.dtype).at[src_tok].add(yb * src_w[:, None].astype(h.dtype))
    return out.reshape(B, L, D)


def setup_inputs(seed: int = 0) -> dict:
    key = jax.random.key(seed)
    ks = iter(jax.random.split(key, 40))

    def nrm(shape, scale):
        return jax.random.normal(next(ks), shape, F32) * scale

    D = D_MODEL
    return {
        'x': nrm((BATCH, SEQ, D), 1.0),
        'ln_in_g': 1.0 + nrm((D,), 0.02),
        'ln_in_b': nrm((D,), 0.02),
        'w_in': nrm((DEPTH, D, D_IN), D ** -0.5),
        'hy_conv_w': nrm((DEPTH, SHORT_CONV, 3 * D_HYENA), SHORT_CONV ** -0.5),
        'hy_conv_b': nrm((DEPTH, 3 * D_HYENA), 0.02),
        'hy_fw1': nrm((DEPTH, FILTER_EMB, FILTER_HIDDEN), FILTER_EMB ** -0.5),
        'hy_fb1': nrm((DEPTH, FILTER_HIDDEN), 0.1),
        'hy_fw2': nrm((DEPTH, FILTER_HIDDEN, FILTER_HIDDEN), FILTER_HIDDEN ** -0.5),
        'hy_fb2': nrm((DEPTH, FILTER_HIDDEN), 0.1),
        'hy_fw3': nrm((DEPTH, FILTER_HIDDEN, 2 * D_HYENA), 0.05 * FILTER_HIDDEN ** -0.5),
        'hy_freq': 1.0 + nrm((DEPTH, 2, FILTER_HIDDEN), 0.1),
        'hy_bias': nrm((DEPTH, D_HYENA), 1.0),
        'q_norm_g': 1.0 + nrm((DEPTH, HEAD_DIM), 0.02),
        'k_norm_g': 1.0 + nrm((DEPTH, HEAD_DIM), 0.02),
        'w_hy_br': nrm((DEPTH, D_HYENA, D), D_HYENA ** -0.5),
        'w_att_br': nrm((DEPTH, D_ATTN, D), D_ATTN ** -0.5),
        'w_o': nrm((DEPTH, D, D), D ** -0.5 * DEEPNORM_BETA),
        'ln_mix_g': 1.0 + nrm((DEPTH, D), 0.02),
        'ln_mix_b': nrm((DEPTH, D), 0.02),
        'ffn_w_gate': nrm((N_DENSE, D, D_FF), D ** -0.5),
        'ffn_w_up': nrm((N_DENSE, D, D_FF), D ** -0.5),
        'ffn_w_down': nrm((N_DENSE, D_FF, D), D_FF ** -0.5 * DEEPNORM_BETA),
        'router_w': nrm((N_MOE, D, N_EXPERTS), D ** -0.5),
        'router_b': nrm((N_MOE, N_EXPERTS), 0.01),
        'exp_w_gate': nrm((N_MOE, N_EXPERTS, D, D_FF_EXPERT), D ** -0.5),
        'exp_w_up': nrm((N_MOE, N_EXPERTS, D, D_FF_EXPERT), D ** -0.5),
        'exp_w_down': nrm((N_MOE, N_EXPERTS, D_FF_EXPERT, D), D_FF_EXPERT ** -0.5 * DEEPNORM_BETA),
        'ln_ffn_g': 1.0 + nrm((DEPTH, D), 0.02),
        'ln_ffn_b': nrm((DEPTH, D), 0.02),
    }


def reference(x, ln_in_g, ln_in_b, w_in, hy_conv_w, hy_conv_b, hy_fw1, hy_fb1, hy_fw2, hy_fb2, hy_fw3,
              hy_freq, hy_bias, q_norm_g, k_norm_g, w_hy_br, w_att_br, w_o, ln_mix_g, ln_mix_b,
              ffn_w_gate, ffn_w_up, ffn_w_down, router_w, router_b, exp_w_gate, exp_w_up, exp_w_down,
              ln_ffn_g, ln_ffn_b):
    h = layer_norm(x, ln_in_g, ln_in_b)
    for i in range(DEPTH):
        mix = hybrid_mixer(h, w_in[i], hy_conv_w[i], hy_conv_b[i], hy_fw1[i], hy_fb1[i], hy_fw2[i],
                           hy_fb2[i], hy_fw3[i], hy_freq[i], hy_bias[i], q_norm_g[i], k_norm_g[i],
                           w_hy_br[i], w_att_br[i], w_o[i])
        h = layer_norm(DEEPNORM_ALPHA * h + mix, ln_mix_g[i], ln_mix_b[i])
        j = i // 2
        if i % 2 == 0:
            f = dense_swiglu(h, ffn_w_gate[j], ffn_w_up[j], ffn_w_down[j])
        else:
            f = moe_swiglu(h, router_w[j], router_b[j], exp_w_gate[j], exp_w_up[j], exp_w_down[j])
        h = layer_norm(DEEPNORM_ALPHA * h + f, ln_ffn_g[i], ln_ffn_b[i])
    return h
```

```cpp
#include <hip/hip_runtime.h>
#include <cstdio>
#include <cstdint>
#include <cstring>

#define LAS __attribute__((address_space(3)))
typedef unsigned short bf16;
typedef short bf16x8 __attribute__((ext_vector_type(8)));
typedef float f32x4 __attribute__((ext_vector_type(4)));
typedef float f32x2 __attribute__((ext_vector_type(2)));
typedef unsigned u32x4 __attribute__((ext_vector_type(4)));
typedef unsigned u32x2 __attribute__((ext_vector_type(2)));

constexpr int NB = 16, SEQ = 2048, DM = 2048, NT = NB * SEQ;
constexpr int DH = 1024, DA = 1024, DKV = 256, DIN = 3 * DH + DA + 2 * DKV + 2 * DM;
constexpr int O_Q = 3 * DH, O_K = O_Q + DA, O_V = O_K + DKV, O_G = O_V + DKV;
constexpr int FF = 5632, FE = 7168, NE = 8;
constexpr float LN_EPS = 1e-5f, RMS_EPS = 1e-6f;
constexpr float ALPHA = 1.41421356237309515f;
constexpr float QSCALE = 0.125f * 1.4426950408889634f;
constexpr int MAXTILES = 264;
constexpr int CHUNK_TILES = 264;
#ifndef MK_QK_EPI
#define MK_QK_EPI 1
#endif
#ifndef MK_DENSE_DN_F8
#define MK_DENSE_DN_F8 1
#endif
#ifndef MK_I8_GATES
#define MK_I8_GATES 1
#endif
#ifndef MK_I8_PROJ
#define MK_I8_PROJ 3
#endif
#ifndef MK_I8_QKV_BF16
#define MK_I8_QKV_BF16 0
#endif
#ifndef MK_WO_I8
#define MK_WO_I8 1
#endif
#ifndef MK_WO_F8
#define MK_WO_F8 0
#endif
#ifndef MK_I8_MOE
#define MK_I8_MOE 1
#endif
#ifndef MK_DENSE_I8
#define MK_DENSE_I8 1
#endif
#ifndef MK_DENSE_F8
#define MK_DENSE_F8 0
#endif
constexpr float SC_GU = 32.f, SC_DN = 128.f;

constexpr size_t MiB = 1u << 20;
constexpr size_t WS_CTL = 0;
constexpr size_t WS_ROPE = 1 * MiB;
constexpr size_t WS_TOK = 2 * MiB;
constexpr size_t WS_GF = 3 * MiB;
constexpr size_t WS_GB = 11 * MiB;
constexpr size_t WS_WIN = 19 * MiB;
constexpr size_t WS_WING = WS_WIN + 36 * MiB;
constexpr int NPB = O_G;
constexpr size_t WS_WHB = 87 * MiB;
constexpr size_t WS_WAB = 95 * MiB;
constexpr size_t WS_WO = 103 * MiB;
constexpr size_t WS_WGU = 119 * MiB;
constexpr size_t WS_WD = 163 * MiB;
constexpr size_t WS_EGU = 185 * MiB;
constexpr size_t WS_HF8 = 409 * MiB;
constexpr size_t WS_M8 = 19 * MiB;
constexpr size_t WS_XBUF = 480 * MiB;
constexpr size_t WS_ED = 633 * MiB;
constexpr size_t WS_H0 = 857 * MiB;
constexpr size_t WS_H1 = 985 * MiB;
constexpr size_t WS_PROJ = 1113 * MiB;
constexpr size_t WS_YHY = 1657 * MiB;
constexpr size_t WS_PT = 1721 * MiB;
constexpr size_t WS_END_MIX = 1785 * MiB;
constexpr size_t WS_G = WS_PROJ;
constexpr size_t WS_XG = WS_PROJ;
constexpr size_t WS_YG = WS_PROJ;
constexpr size_t WS_HM = WS_PROJ + 264 * MiB;
constexpr size_t WS_WIN8 = WS_HM + 462 * MiB;
constexpr size_t WS_END = WS_WIN8 + 34 * MiB;
constexpr int CW_CNT = 64;
constexpr int CW_NTILES = 128;
constexpr int CW_TILE_E = 192;
constexpr int CW_TBASE = 512;
constexpr int CW_AMAX = 1024;
constexpr int CW_SSQ = 1040;
constexpr float I8_ACLIP = 4.25f;
constexpr float I8_WCLIP = 4.25f;
constexpr int CW_TMO = 0;
constexpr int CW_PANEL = 8192;

struct Params {
    const float* in[30];
    float* out;
    unsigned char* ws;
    int ph_lo, ph_hi;
};

typedef const __attribute__((address_space(4))) Params* KP;
__device__ __forceinline__ unsigned f2bf(float f) { unsigned u = __float_as_uint(f); return (u + 0x7fffu + ((u >> 16) & 1u)) >> 16; }
__device__ __forceinline__ unsigned pk2(float lo, float hi) { return f2bf(lo) | (f2bf(hi) << 16); }
__device__ __forceinline__ float bflo(unsigned w) { return __uint_as_float(w << 16); }
__device__ __forceinline__ float bfhi(unsigned w) { return __uint_as_float(w & 0xffff0000u); }
__device__ __forceinline__ float bf2f(bf16 b) { return __uint_as_float(((unsigned)b) << 16); }
__device__ __forceinline__ unsigned pk4_fp8(float a, float b, float c, float d) { int w = __builtin_amdgcn_cvt_pk_fp8_f32(a, b, 0, false); w = __builtin_amdgcn_cvt_pk_fp8_f32(c, d, w, true); return (unsigned)w; }
__device__ __forceinline__ unsigned pk4_i8(float a, float b, float c, float d, float qs) {
    const float M = 12582912.0f;
    const unsigned ua = __float_as_uint(__builtin_amdgcn_fmed3f(a * qs, -127.f, 127.f) + M), ub = __float_as_uint(__builtin_amdgcn_fmed3f(b * qs, -127.f, 127.f) + M);
    const unsigned uc = __float_as_uint(__builtin_amdgcn_fmed3f(c * qs, -127.f, 127.f) + M), ud = __float_as_uint(__builtin_amdgcn_fmed3f(d * qs, -127.f, 127.f) + M);
    return __builtin_amdgcn_perm(ub, ua, 0x0c0c0400u) | __builtin_amdgcn_perm(ud, uc, 0x04000c0cu);
}
template <int M> __device__ __forceinline__ float swz_xor(float v) { return __int_as_float(__builtin_amdgcn_ds_swizzle(__float_as_int(v), 0x1f | (M << 10))); }
__device__ __forceinline__ float wave_sum(float v) {
    v += swz_xor<1>(v); v += swz_xor<2>(v); v += swz_xor<4>(v); v += swz_xor<8>(v); v += swz_xor<16>(v);
    const auto rr = __builtin_amdgcn_permlane32_swap(__float_as_uint(v), __float_as_uint(v), false, false);
    return __uint_as_float(rr[0]) + __uint_as_float(rr[1]);
}
__device__ __forceinline__ int lane_id() { int l; asm volatile("v_mbcnt_lo_u32_b32 %0, -1, 0\n\tv_mbcnt_hi_u32_b32 %0, -1, %0" : "=v"(l)); return l; }
__device__ __forceinline__ int opaque_tid(int wv) { int t = (wv << 6) | lane_id(); asm volatile("" : "+v"(t)); return t; }
__device__ __forceinline__ float sigmoidf_(float x) { return 1.0f / (1.0f + __expf(-x)); }

__device__ __forceinline__ void transpose_item(const float* W, int K, int N, bf16* WT, int orow0, int k0, int n0, LAS float* scr, int lane) {
#pragma unroll 8
    for (int i = 0; i < 32; ++i) { const int kk = 2 * i + (lane >> 5); scr[kk * 33 + (lane & 31)] = W[(size_t)(k0 + kk) * N + n0 + (lane & 31)]; }
    asm volatile("s_waitcnt lgkmcnt(0)" ::: "memory");
    const int c = lane & 7;
#pragma unroll
    for (int j = 0; j < 4; ++j) { const int n = (lane >> 3) + 8 * j; const LAS float* s = scr + (8 * c) * 33 + n;
        u32x4 o; o.x = pk2(s[0 * 33], s[1 * 33]); o.y = pk2(s[2 * 33], s[3 * 33]); o.z = pk2(s[4 * 33], s[5 * 33]); o.w = pk2(s[6 * 33], s[7 * 33]);
        *(u32x4*)(WT + (size_t)(orow0 + n) * K + k0 + 8 * c) = o; }
    asm volatile("s_waitcnt lgkmcnt(0)" ::: "memory");
}
__device__ __forceinline__ void transpose_item_f8(const float* W, int K, int N, unsigned char* WT, int orow0, int k0, int n0, float scale, LAS float* scr, int lane) {
#pragma unroll 8
    for (int i = 0; i < 64; ++i) { const int kk = 2 * i + (lane >> 5); scr[kk * 33 + (lane & 31)] = W[(size_t)(k0 + kk) * N + n0 + (lane & 31)]; }
    asm volatile("s_waitcnt lgkmcnt(0)" ::: "memory");
    const int c = lane & 7;
#pragma unroll
    for (int j = 0; j < 4; ++j) { const int n = (lane >> 3) + 8 * j; const LAS float* s = scr + (16 * c) * 33 + n;
        u32x4 o; o.x = pk4_fp8(s[0 * 33] * scale, s[1 * 33] * scale, s[2 * 33] * scale, s[3 * 33] * scale); o.y = pk4_fp8(s[4 * 33] * scale, s[5 * 33] * scale, s[6 * 33] * scale, s[7 * 33] * scale);
        o.z = pk4_fp8(s[8 * 33] * scale, s[9 * 33] * scale, s[10 * 33] * scale, s[11 * 33] * scale); o.w = pk4_fp8(s[12 * 33] * scale, s[13 * 33] * scale, s[14 * 33] * scale, s[15 * 33] * scale);
        *(u32x4*)(WT + (size_t)(orow0 + n) * K + k0 + 16 * c) = o; }
    asm volatile("s_waitcnt lgkmcnt(0)" ::: "memory");
}
__device__ __forceinline__ void transpose_item_i8(const float* W, int K, int N, unsigned char* WT, int orow0, int k0, int n0, float scale, LAS float* scr, int lane) {
#pragma unroll 8
    for (int i = 0; i < 64; ++i) { const int kk = 2 * i + (lane >> 5); scr[kk * 33 + (lane & 31)] = W[(size_t)(k0 + kk) * N + n0 + (lane & 31)]; }
    asm volatile("s_waitcnt lgkmcnt(0)" ::: "memory");
    const int c = lane & 7;
#pragma unroll
    for (int j = 0; j < 4; ++j) { const int n = (lane >> 3) + 8 * j; const LAS float* s = scr + (16 * c) * 33 + n;
        u32x4 o; o.x = pk4_i8(s[0 * 33], s[1 * 33], s[2 * 33], s[3 * 33], scale); o.y = pk4_i8(s[4 * 33], s[5 * 33], s[6 * 33], s[7 * 33], scale);
        o.z = pk4_i8(s[8 * 33], s[9 * 33], s[10 * 33], s[11 * 33], scale); o.w = pk4_i8(s[12 * 33], s[13 * 33], s[14 * 33], s[15 * 33], scale);
        *(u32x4*)(WT + (size_t)(orow0 + n) * K + k0 + 16 * c) = o; }
    asm volatile("s_waitcnt lgkmcnt(0)" ::: "memory");
}
__device__ __forceinline__ float wave_max(float v) {
    v = fmaxf(v, swz_xor<1>(v)); v = fmaxf(v, swz_xor<2>(v)); v = fmaxf(v, swz_xor<4>(v)); v = fmaxf(v, swz_xor<8>(v)); v = fmaxf(v, swz_xor<16>(v));
    const auto rr = __builtin_amdgcn_permlane32_swap(__float_as_uint(v), __float_as_uint(v), false, false);
    return fmaxf(__uint_as_float(rr[0]), __uint_as_float(rr[1]));
}
__device__ __forceinline__ void ssq_rows(const float* base, int rows, int N, int stride, unsigned long long* dst, int vb, int G, int tid) {
    const int N4 = N / 4, total = (rows / stride) * N4; float s = 0.f;
    for (int i = vb * 512 + tid; i < total; i += G * 512) { const int r = i / N4, c = i - r * N4; const f32x4 x = ((const f32x4*)(base + (size_t)r * stride * N))[c]; s += (x.x * x.x + x.y * x.y) + (x.z * x.z + x.w * x.w); }
    s = wave_sum(s); if ((tid & 63) == 0) atomicAdd(dst, (unsigned long long)(s * 4294967296.0f));
}
constexpr int I8_S0 = 8, I8_S1 = 8, I8_S2 = 32;
__device__ __forceinline__ void ph_wstats(KP p, int vb, int G, int wv) {
    const int tid = opaque_tid(wv); unsigned* ctl = (unsigned*)(p->ws + WS_CTL); unsigned long long* sq = (unsigned long long*)(ctl + CW_SSQ);
    if (MK_DENSE_I8) { ssq_rows(p->in[20], DM, FF, I8_S0, sq + 0, vb, G, tid); ssq_rows(p->in[21], DM, FF, I8_S0, sq + 0, vb, G, tid); }
    if (MK_I8_GATES) ssq_rows(p->in[3], 2 * DM, DIN, I8_S1, sq + 1, vb, G, tid);
    if (MK_WO_I8) ssq_rows(p->in[17], 2 * DM, DM, I8_S1, sq + 3, vb, G, tid);
    if (MK_I8_MOE) { ssq_rows(p->in[25], 8 * DM, FE, I8_S2, sq + 2, vb, G, tid); ssq_rows(p->in[26], 8 * DM, FE, I8_S2, sq + 2, vb, G, tid); }
    if (vb < 4) { const float* g = vb == 0 ? p->in[1] : (vb == 1 ? p->in[18] : (vb == 2 ? p->in[28] : p->in[18] + DM)); const float* b = vb == 0 ? p->in[2] : (vb == 1 ? p->in[19] : (vb == 2 ? p->in[29] : p->in[19] + DM));
        const float mg = wave_max(fmaxf(fmaxf(fabsf(g[tid]), fabsf(g[tid + 512])), fmaxf(fabsf(g[tid + 1024]), fabsf(g[tid + 1536]))));
        const float mb = wave_max(fmaxf(fmaxf(fabsf(b[tid]), fabsf(b[tid + 512])), fmaxf(fabsf(b[tid + 1024]), fabsf(b[tid + 1536]))));
        if ((tid & 63) == 0) { atomicMax(ctl + CW_AMAX + 2 * vb, __float_as_uint(mg)); atomicMax(ctl + CW_AMAX + 2 * vb + 1, __float_as_uint(mb)); } }
}
__device__ __forceinline__ float ctl_f(KP p, int w) { return __uint_as_float(__hip_atomic_load((unsigned*)(p->ws + WS_CTL) + w, __ATOMIC_RELAXED, __HIP_MEMORY_SCOPE_AGENT)); }
__device__ __forceinline__ float i8_range_a(KP p, int site) { return fmaxf(I8_ACLIP * ctl_f(p, CW_AMAX + 2 * site) + ctl_f(p, CW_AMAX + 2 * site + 1), 1e-30f); }
__device__ __forceinline__ float i8_range_w(KP p, int gid) {
    const unsigned long long v = __hip_atomic_load((unsigned long long*)((unsigned*)(p->ws + WS_CTL) + CW_SSQ) + gid, __ATOMIC_RELAXED, __HIP_MEMORY_SCOPE_AGENT);
    const float cnt = gid == 0 ? 2.0f * (DM / I8_S0) * FF : (gid == 1 ? (2.0f * DM / I8_S1) * DIN : (gid == 3 ? (2.0f * DM / I8_S1) * DM : 2.0f * (8 * DM / I8_S2) * FE));
    return fmaxf(I8_WCLIP * sqrtf((float)v * (1.0f / 4294967296.0f) / cnt), 1e-30f);
}
struct TrItem { const float* src; size_t dstb; int ld, K, kbk, mode, d, n0, k0, c0; float sc; };
__device__ __forceinline__ int tr_decode(KP p, int it, float qw0, float qw1, float qw2, float qw3, TrItem& I) {
    constexpr int ND = 12;
    constexpr int d_src[ND] = {3, 3, 15, 16, 17, 20, 21, 22, 25, 26, 27, 3};
    constexpr int d_K[ND] = {2048, 2048, 1024, 1024, 2048, 2048, 2048, 5632, 2048, 2048, 7168, 2048};
    constexpr int d_N[ND] = {MK_I8_PROJ == 3 ? (MK_I8_QKV_BF16 == 1 ? O_G - O_Q : (MK_I8_QKV_BF16 == 2 ? O_Q : 0)) : NPB, MK_I8_PROJ == 3 ? 0 : 4096, 2048, 2048, 2048, 5632, 5632, 2048, 7168, 7168, 2048, MK_I8_PROJ ? DIN : 0};
    constexpr int d_ld[ND] = {DIN, DIN, 2048, 2048, 2048, 5632, 5632, 2048, 7168, 7168, 2048, DIN};
    constexpr int d_c0[ND] = {(MK_I8_PROJ == 3 && MK_I8_QKV_BF16 == 1) ? O_Q : 0, NPB, 0, 0, 0, 0, 0, 0, 0, 0, 0, 0};
    constexpr int d_mode[ND] = {0, 0, 0, 0, 0, 1, 2, 0, 1, 2, 0, 0};
    constexpr int d_nb[ND] = {2, 2, 2, 2, 2, 1, 1, 1, 8, 8, 8, 2};
    constexpr int DKB = (MK_DENSE_F8 || MK_DENSE_I8) ? 128 : 64, DKD = (MK_DENSE_F8 || MK_DENSE_DN_F8) ? 128 : 64;
    constexpr int d_kb[ND] = {64, 128, 64, 64, (MK_WO_F8 || MK_WO_I8) ? 128 : 64, DKB, DKB, DKD, 128, 128, 128, 128};
    constexpr float d_sc[ND] = {1.f, SC_GU, 1.f, 1.f, MK_WO_F8 ? 64.f : 1.f, MK_DENSE_F8 ? SC_GU : 1.f, MK_DENSE_F8 ? SC_GU : 1.f, (MK_DENSE_F8 || MK_DENSE_DN_F8) ? SC_DN : 1.f, SC_GU, SC_GU, SC_DN, 1.f};
    constexpr size_t d_dst[ND] = {WS_WIN, WS_WING, WS_WHB, WS_WAB, WS_WO, WS_WGU, WS_WGU, WS_WD, WS_EGU, WS_EGU, WS_ED, WS_WIN8};
    if (it < 0) { int total = 0;
#pragma unroll
        for (int d = 0; d < ND; ++d) total += d_nb[d] * (d_K[d] / 128) * (d_N[d] / 256);
        return total; }

        int r = it, d = 0;
#pragma unroll
        for (int q = 0; q < ND - 1; ++q) { const int cnt = d_nb[q] * (d_K[q] / 128) * (d_N[q] / 256); if (d == q && r >= cnt) { r -= cnt; d = q + 1; } }
        int K = 0, N = 0, mode = 0, src = 0, kbk = 64, ld = 0, c0 = 0; size_t dst = 0; float sc = 1.f;
#pragma unroll
        for (int q = 0; q < ND; ++q) if (d == q) { K = d_K[q]; N = d_N[q]; mode = d_mode[q]; src = d_src[q]; dst = d_dst[q]; kbk = d_kb[q]; sc = d_sc[q]; ld = d_ld[q]; c0 = d_c0[q]; }
        const int nblk = N / 256, per_b = (K / 128) * nblk, bi = r / per_b, rr = r % per_b, kb = rr / nblk, nbk = rr % nblk;
        const bool i8 = (MK_DENSE_I8 && (d == 5 || d == 6)) || (MK_I8_GATES && d == 1) || (d == 11) || (MK_I8_MOE && (d == 8 || d == 9)) || (MK_WO_I8 && d == 4);
        I.k0 = kb * 128; I.n0 = nbk * 256; I.c0 = c0; I.ld = ld; I.K = K; I.kbk = kbk; I.mode = mode; I.d = i8 ? 100 + d : d;
        I.sc = i8 ? (d == 4 ? qw3 : ((d == 1 || d == 11) ? qw1 : (d < 8 ? qw0 : qw2))) : sc;
        I.src = p->in[src] + (size_t)bi * K * ld + c0 + (size_t)I.k0 * ld + I.n0;
        I.dstb = dst + (size_t)bi * (mode ? 2 : 1) * N * K * (kbk == 64 ? 2 : 1);
        return 0;
}
__device__ __forceinline__ void ph_transpose(KP p, LAS unsigned char* lds, int vb, int G, int wv) {
    const int tid = opaque_tid(wv), lane = tid & 63, wave = tid >> 6;
    LAS float* scr = (LAS float*)lds; constexpr int PITCH = 257;
    const float qw0 = MK_DENSE_I8 ? 127.0f / i8_range_w(p, 0) : 0.f, qw1 = MK_I8_GATES ? 127.0f / i8_range_w(p, 1) : 0.f, qw2 = MK_I8_MOE ? 127.0f / i8_range_w(p, 2) : 0.f, qw3 = MK_WO_I8 ? 127.0f / i8_range_w(p, 3) : 0.f;
    TrItem dummy; const int total = tr_decode(p, -1, qw0, qw1, qw2, qw3, dummy);
    float v[16][4];
    auto issue = [&](const TrItem& I) {
#pragma unroll
        for (int j = 0; j < 16; ++j) { const float* rp = I.src + (size_t)(wave + 8 * j) * I.ld + lane;
#pragma unroll
            for (int i = 0; i < 4; ++i) v[j][i] = rp[64 * i]; }
    };
    TrItem cur, nxt; int it = vb;
    if (it < total) { tr_decode(p, it, qw0, qw1, qw2, qw3, cur); issue(cur); }
    for (; it < total; it += G) {
        __syncthreads();
#pragma unroll
        for (int j = 0; j < 16; ++j)
#pragma unroll
            for (int i = 0; i < 4; ++i) scr[(wave + 8 * j) * PITCH + lane + 64 * i] = v[j][i];
        __syncthreads();
        const bool has_next = it + G < total;
        if (has_next) { tr_decode(p, it + G, qw0, qw1, qw2, qw3, nxt); issue(nxt); }
        const int dd = cur.d >= 100 ? cur.d - 100 : cur.d; const bool i8 = cur.d >= 100;
        auto orow_of = [&](int n) -> size_t { const int na = cur.n0 + n, nb = na & ~31;
            int o = cur.mode == 0 ? nb : (nb / 128) * 256 + (nb % 128) + (cur.mode == 2 ? 128 : 0);
            if (MK_QK_EPI && (dd == 0 || dd == 11) && nb + cur.c0 >= O_Q && nb + cur.c0 < O_V) o = (nb & ~255) + 128 * ((nb >> 5) & 1) + 32 * ((nb >> 6) & 3);
            return (size_t)(o + (na & 31)); };
        if (cur.kbk == 64) {
#pragma unroll
            for (int j = 0; j < 8; ++j) { const int q = tid + 512 * j, n = q >> 4, c = q & 15; const LAS float* s = scr + (8 * c) * PITCH + n;
                u32x4 w; w.x = pk2(s[0 * PITCH], s[1 * PITCH]); w.y = pk2(s[2 * PITCH], s[3 * PITCH]); w.z = pk2(s[4 * PITCH], s[5 * PITCH]); w.w = pk2(s[6 * PITCH], s[7 * PITCH]);
                *(u32x4*)((bf16*)(p->ws + cur.dstb) + orow_of(n) * cur.K + cur.k0 + 8 * c) = w; }
        } else {
#pragma unroll
            for (int j = 0; j < 4; ++j) { const int q = tid + 512 * j, n = q >> 3, c = q & 7; const LAS float* s = scr + (16 * c) * PITCH + n; const float sc = cur.sc; u32x4 w;
                if (i8) { w.x = pk4_i8(s[0 * PITCH], s[1 * PITCH], s[2 * PITCH], s[3 * PITCH], sc); w.y = pk4_i8(s[4 * PITCH], s[5 * PITCH], s[6 * PITCH], s[7 * PITCH], sc);
                          w.z = pk4_i8(s[8 * PITCH], s[9 * PITCH], s[10 * PITCH], s[11 * PITCH], sc); w.w = pk4_i8(s[12 * PITCH], s[13 * PITCH], s[14 * PITCH], s[15 * PITCH], sc); }
                else { w.x = pk4_fp8(s[0 * PITCH] * sc, s[1 * PITCH] * sc, s[2 * PITCH] * sc, s[3 * PITCH] * sc); w.y = pk4_fp8(s[4 * PITCH] * sc, s[5 * PITCH] * sc, s[6 * PITCH] * sc, s[7 * PITCH] * sc);
                       w.z = pk4_fp8(s[8 * PITCH] * sc, s[9 * PITCH] * sc, s[10 * PITCH] * sc, s[11 * PITCH] * sc); w.w = pk4_fp8(s[12 * PITCH] * sc, s[13 * PITCH] * sc, s[14 * PITCH] * sc, s[15 * PITCH] * sc); }
                *(u32x4*)(p->ws + cur.dstb + orow_of(n) * cur.K + cur.k0 + 16 * c) = w; }
        }
        cur = nxt;
    }
    __syncthreads();
}
__device__ __forceinline__ void ln_row_stats(f32x4 (&v)[8], float& mean, float& rstd) {
    float s = 0.f;
#pragma unroll
    for (int j = 0; j < 8; ++j) s += (v[j].x + v[j].y) + (v[j].z + v[j].w);
    mean = wave_sum(s) * (1.f / DM); float s2 = 0.f;
#pragma unroll
    for (int j = 0; j < 8; ++j) { const f32x4 d = v[j] - mean; s2 += (d.x * d.x + d.y * d.y) + (d.z * d.z + d.w * d.w); }
    rstd = 1.f / sqrtf(wave_sum(s2) * (1.f / DM) + LN_EPS);
}
__device__ __forceinline__ void ph_ln_in(KP p, int vb, int G, int wv) {
    const int tid_ = opaque_tid(wv); const int lane = tid_ & 63, wave = tid_ >> 6; const int gw = vb * 8 + wave, NGW = G * 8;
    const f32x4* g4 = (const f32x4*)p->in[1]; const f32x4* b4 = (const f32x4*)p->in[2];
    bf16* H0 = (bf16*)(p->ws + WS_H0); const float q8 = MK_I8_GATES ? 127.0f / i8_range_a(p, 0) : 0.f;
    for (int m0 = gw; m0 < NT; m0 += 2 * NGW) {
        f32x4 v[2][8];
#pragma unroll
        for (int k = 0; k < 2; ++k) { const int m = m0 + k * NGW; const int mm = m < NT ? m : NT - 1; const f32x4* xr = (const f32x4*)(p->in[0] + (size_t)mm * DM);
#pragma unroll
            for (int j = 0; j < 8; ++j) v[k][j] = xr[lane + 64 * j]; }
#pragma unroll
        for (int k = 0; k < 2; ++k) { const int m = m0 + k * NGW; if (m < NT) {
            float mean, rstd; ln_row_stats(v[k], mean, rstd);
            u32x2* o = (u32x2*)(H0 + (size_t)m * DM); unsigned* o8 = (unsigned*)(p->ws + WS_HF8 + (size_t)m * DM);
#pragma unroll
            for (int j = 0; j < 8; ++j) { const f32x4 g = g4[lane + 64 * j], b = b4[lane + 64 * j]; const f32x4 y = (v[k][j] - mean) * rstd * g + b;
                u32x2 w; w.x = pk2(y.x, y.y); w.y = pk2(y.z, y.w); o[lane + 64 * j] = w; o8[lane + 64 * j] = MK_I8_GATES ? pk4_i8(y.x, y.y, y.z, y.w, q8) : pk4_fp8(y.x, y.y, y.z, y.w); } } }
    }
}
__device__ __forceinline__ void ph_rope(KP p, int vb, int G, int wv) {
    float* ct = (float*)(p->ws + WS_ROPE); float* st = ct + SEQ * 32;
    for (int i = vb * 512 + opaque_tid(wv); i < SEQ * 32; i += G * 512) {
        const int pos = i >> 5, pp = i & 31;
        const double inv = pow(10000.0, -(double)(pp & 15) / 16.0);
        const double ang = (double)(pp < 16 ? (pos >> 6) : (pos & 63)) * inv;
        ct[i] = (float)cos(ang); st[i] = (float)sin(ang);
    }
}
__device__ __forceinline__ void ph_filter(KP p, LAS unsigned char* lds, int vb, int G, int wv) {
    const int tid = opaque_tid(wv);
    LAS float* z = (LAS float*)lds;
    LAS float* a1 = z + 16 * 36;
    LAS float* a2 = a1 + 16 * 64;
    for (int u = vb; u < 256; u += G) {
        const int l = u >> 7, n0 = (u & 127) * 16;
        const float* fw1 = p->in[6] + l * 33 * 64; const float* fb1 = p->in[7] + l * 64; const float* fw2 = p->in[8] + l * 64 * 64; const float* fb2 = p->in[9] + l * 64;
        const float* fw3 = p->in[10] + (size_t)l * 64 * 2048; const float* fr = p->in[11] + l * 128; const float* hb = p->in[12] + l * 1024;
        __syncthreads();
        for (int idx = tid; idx < 16 * 33; idx += 512) { const int pp = idx / 33, i = idx % 33; const int n = n0 + pp; float val;
            if (i == 0) val = (float)n / 2047.0f;
            else { const int j = (i - 1) & 15; const double f = (double)(1e-4f + (float)j * ((15.0f - 1e-4f) / 15.0f)); const double w = 2.0 * 3.14159265358979323846 * (double)n / 2048.0;
                   val = (i <= 16) ? (float)cos(f * w) : -(float)sin(f * w); }
            z[pp * 36 + i] = val; }
        __syncthreads();
        for (int o = tid; o < 1024; o += 512) { const int pp = o >> 6, h = o & 63; float s = fb1[h];
            for (int i = 0; i < 33; ++i) s += z[pp * 36 + i] * fw1[i * 64 + h];
            a1[pp * 64 + h] = sinf(fr[h] * s); }
        __syncthreads();
        for (int o = tid; o < 1024; o += 512) { const int pp = o >> 6, h = o & 63; float s = fb2[h];
            for (int i = 0; i < 64; ++i) s += a1[pp * 64 + i] * fw2[i * 64 + h];
            a2[pp * 64 + h] = sinf(fr[64 + h] * s); }
        __syncthreads();
        const int col4 = tid * 4; f32x4 acc[16];
#pragma unroll
        for (int pp = 0; pp < 16; ++pp) acc[pp] = (f32x4){0.f, 0.f, 0.f, 0.f};
        for (int i = 0; i < 64; ++i) { const f32x4 w4 = *(const f32x4*)(fw3 + (size_t)i * 2048 + col4);
#pragma unroll
            for (int pp = 0; pp < 16; ++pp) acc[pp] += a2[pp * 64 + i] * w4; }
        const bool bwd = col4 >= 1024; const int c0 = col4 & 1023;
        const float mind = -3.0701134573253944f, maxd = -15.350567286626973f;
        bf16* Gd = (bf16*)(p->ws + (bwd ? WS_GB : WS_GF)) + (size_t)l * 1024 * 2048;
#pragma unroll
        for (int j = 0; j < 4; ++j) { const int c = c0 + j; const float delta = fabsf(mind + (float)c * ((maxd - mind) / 1023.0f)); float vals[16];
#pragma unroll
            for (int pp = 0; pp < 16; ++pp) { const int n = n0 + pp; const float tn = (float)n / 2047.0f; float v = acc[pp][j] * expf(-tn * delta);
                if (n == 0) v = bwd ? 0.f : v + hb[c]; vals[pp] = v; }
            u32x4 w0, w1; w0.x = pk2(vals[0], vals[1]); w0.y = pk2(vals[2], vals[3]); w0.z = pk2(vals[4], vals[5]); w0.w = pk2(vals[6], vals[7]);
            w1.x = pk2(vals[8], vals[9]); w1.y = pk2(vals[10], vals[11]); w1.z = pk2(vals[12], vals[13]); w1.w = pk2(vals[14], vals[15]);
            u32x4* dst = (u32x4*)(Gd + (size_t)c * 2048 + n0); dst[0] = w0; dst[1] = w1; }
    }
}
__device__ __forceinline__ void ph_qk_prep(KP p, int layer, int vb, int G, int wv) {
    const int tid_ = opaque_tid(wv); const int lane = tid_ & 63, wave = tid_ >> 6; const int gw = vb * 8 + wave, NGW = G * 8;
    bf16* PROJ = (bf16*)(p->ws + WS_PROJ); const float* ct = (const float*)(p->ws + WS_ROPE); const float* st = ct + SEQ * 32;
    const float* qg = p->in[13] + layer * 64; const float* kg = p->in[14] + layer * 64;
    const int l16 = lane & 15, hsub = lane >> 4;
    for (int m = gw; m < NT; m += NGW) {
        const int pos = m & (SEQ - 1);
        const f32x2 c2 = *(const f32x2*)(ct + pos * 32 + 2 * l16), s2 = *(const f32x2*)(st + pos * 32 + 2 * l16);
#pragma unroll
        for (int g = 0; g < 5; ++g) {
            const int hh = 4 * g + hsub;
            unsigned* base = (unsigned*)(PROJ + (size_t)m * DIN + O_Q + hh * 64);
            const unsigned w1 = base[l16], w2 = base[16 + l16];
            float x0 = bflo(w1), x1 = bfhi(w1), y0 = bflo(w2), y1 = bfhi(w2);
            float ss = x0 * x0 + x1 * x1 + y0 * y0 + y1 * y1;
            ss += swz_xor<1>(ss); ss += swz_xor<2>(ss); ss += swz_xor<4>(ss); ss += swz_xor<8>(ss);
            const float rinv = 1.0f / sqrtf(ss * (1.0f / 64.0f) + RMS_EPS);
            const float* gg = hh < 16 ? qg : kg; const float sc = hh < 16 ? QSCALE : 1.0f;
            const f32x2 ga = *(const f32x2*)(gg + 2 * l16), gb = *(const f32x2*)(gg + 32 + 2 * l16);
            x0 *= rinv * ga.x; x1 *= rinv * ga.y; y0 *= rinv * gb.x; y1 *= rinv * gb.y;
            const float o0 = (x0 * c2.x - y0 * s2.x) * sc, o1 = (x1 * c2.y - y1 * s2.y) * sc, q0 = (y0 * c2.x + x0 * s2.x) * sc, q1 = (y1 * c2.y + x1 * s2.y) * sc;
            base[l16] = pk2(o0, o1); base[16 + l16] = pk2(q0, q1);
        }
    }
}
__device__ __forceinline__ void short_conv_rows(const u32x4 (&raw)[6], bool lo_ok, bool hi_ok, const float* cw, const float* cb, int g, int c0, float (&o)[4][8]) {
    float w0[8], w1[8], w2[8], bb[8];
#pragma unroll
    for (int h = 0; h < 2; ++h) { const f32x4 a = *(const f32x4*)(cw + 0 * 3072 + g * 1024 + c0 + 4 * h), bq = *(const f32x4*)(cw + 1 * 3072 + g * 1024 + c0 + 4 * h), c = *(const f32x4*)(cw + 2 * 3072 + g * 1024 + c0 + 4 * h), d = *(const f32x4*)(cb + g * 1024 + c0 + 4 * h);
#pragma unroll
        for (int e = 0; e < 4; ++e) { w0[4 * h + e] = a[e]; w1[4 * h + e] = bq[e]; w2[4 * h + e] = c[e]; bb[4 * h + e] = d[e]; } }
#pragma unroll
    for (int r = 0; r < 4; ++r)
#pragma unroll
        for (int e = 0; e < 8; ++e) o[r][e] = bb[e];
#pragma unroll
    for (int i = 0; i < 6; ++i) { u32x4 w = raw[i];
        if ((i == 0 && !lo_ok) || (i == 5 && !hi_ok)) w = (u32x4){0u, 0u, 0u, 0u};
        float uu[8]; uu[0] = bflo(w.x); uu[1] = bfhi(w.x); uu[2] = bflo(w.y); uu[3] = bfhi(w.y); uu[4] = bflo(w.z); uu[5] = bfhi(w.z); uu[6] = bflo(w.w); uu[7] = bfhi(w.w);
#pragma unroll
        for (int e = 0; e < 8; ++e) {
            if (i < 4) o[i][e] += w0[e] * uu[e];
            if (i >= 1 && i <= 4) o[i - 1][e] += w1[e] * uu[e];
            if (i >= 2) o[i - 2][e] += w2[e] * uu[e]; } }
}
__device__ __forceinline__ void ph_hy_prep(KP p, int layer, LAS unsigned char* lds, int vb, int G, int wv) {
    const int tid = opaque_tid(wv), cg = tid & 15, rs = tid >> 4;
    const bf16* PROJ = (const bf16*)(p->ws + WS_PROJ); bf16* PT = (bf16*)(p->ws + WS_PT);
    const float* cw = p->in[4] + layer * 3 * 3072; const float* cb = p->in[5] + layer * 3072;
    LAS bf16* tile = (LAS bf16*)lds;
    auto load_u = [&](int u, u32x4 (&raw)[2][6]) {
        const int cblk = u & 7, sblk = (u >> 3) & 15, b = u >> 7; const int c0 = cblk * 128 + cg * 8, s0 = sblk * 128 + rs * 4;
#pragma unroll
        for (int g = 0; g < 2; ++g)
#pragma unroll
            for (int i = 0; i < 6; ++i) { int s = s0 - 1 + i; s = s < 0 ? 0 : (s > SEQ - 1 ? SEQ - 1 : s); raw[g][i] = *(const u32x4*)(PROJ + ((size_t)b * SEQ + s) * DIN + (g + 1) * 1024 + c0); } };
    auto proc_u = [&](int u, const u32x4 (&raw)[2][6]) {
        const int cblk = u & 7, sblk = (u >> 3) & 15, b = u >> 7; const int c0 = cblk * 128 + cg * 8, s0 = sblk * 128 + rs * 4;
        const bool lo_ok = s0 > 0, hi_ok = s0 + 4 < SEQ;
        float o1[4][8], o2[4][8];
        short_conv_rows(raw[0], lo_ok, hi_ok, cw, cb, 1, c0, o1);
        short_conv_rows(raw[1], lo_ok, hi_ok, cw, cb, 2, c0, o2);
        __syncthreads();
#pragma unroll
        for (int e = 0; e < 8; ++e) { u32x2 w; w.x = pk2(o1[0][e] * o2[0][e], o1[1][e] * o2[1][e]); w.y = pk2(o1[2][e] * o2[2][e], o1[3][e] * o2[3][e]);
            *(LAS u32x2*)(tile + (cg * 8 + e) * 136 + rs * 4) = w; }
        __syncthreads();
#pragma unroll
        for (int k = 0; k < 4; ++k) { const int q = tid + 512 * k, ch = q >> 4, part = q & 15;
            const u32x4 w = *(const LAS u32x4*)(tile + ch * 136 + part * 8);
            *(u32x4*)(PT + ((size_t)(cblk * 128 + ch) * NB + b) * SEQ + sblk * 128 + part * 8) = w; } };
    u32x4 ra[2][6], rb[2][6]; int u = vb;
    if (u < 2048) load_u(u, ra);
    for (; u < 2048; u += 2 * G) {
        const bool h1 = u + G < 2048, h2 = u + 2 * G < 2048;
        if (h1) load_u(u + G, rb);
        proc_u(u, ra);
        if (h1) { if (h2) load_u(u + 2 * G, ra); proc_u(u + G, rb); }
    }
}
__device__ __forceinline__ void ph_hy_post(KP p, int layer, LAS unsigned char* lds, int vb, int G, int wv) {
    const int tid = opaque_tid(wv), cg = tid & 15, rs = tid >> 4;
    const bf16* PROJ = (const bf16*)(p->ws + WS_PROJ); bf16* YHY = (bf16*)(p->ws + WS_YHY); const bf16* PT = (const bf16*)(p->ws + WS_PT);
    const float* cw = p->in[4] + layer * 3 * 3072; const float* cb = p->in[5] + layer * 3072;
    LAS bf16* tile = (LAS bf16*)lds;
    auto load_u = [&](int u, u32x4 (&yt)[4], u32x4 (&raw)[6]) {
        const int cblk = u & 7, sblk = (u >> 3) & 15, b = u >> 7; const int c0 = cblk * 128 + cg * 8, s0 = sblk * 128 + rs * 4;
#pragma unroll
        for (int k = 0; k < 4; ++k) { const int q = tid + 512 * k, ch = q >> 4, part = q & 15; yt[k] = *(const u32x4*)(PT + ((size_t)(cblk * 128 + ch) * NB + b) * SEQ + sblk * 128 + part * 8); }
#pragma unroll
        for (int i = 0; i < 6; ++i) { int s = s0 - 1 + i; s = s < 0 ? 0 : (s > SEQ - 1 ? SEQ - 1 : s); raw[i] = *(const u32x4*)(PROJ + ((size_t)b * SEQ + s) * DIN + c0); } };
    auto proc_u = [&](int u, const u32x4 (&yt)[4], const u32x4 (&raw)[6]) {
        const int cblk = u & 7, sblk = (u >> 3) & 15, b = u >> 7; const int c0 = cblk * 128 + cg * 8, s0 = sblk * 128 + rs * 4;
        const bool lo_ok = s0 > 0, hi_ok = s0 + 4 < SEQ;
        __syncthreads();
#pragma unroll
        for (int k = 0; k < 4; ++k) { const int q = tid + 512 * k, ch = q >> 4, part = q & 15; *(LAS u32x4*)(tile + ch * 136 + part * 8) = yt[k]; }
        float o[4][8]; short_conv_rows(raw, lo_ok, hi_ok, cw, cb, 0, c0, o);
        __syncthreads();
#pragma unroll
        for (int r = 0; r < 4; ++r) { float y[8];
#pragma unroll
            for (int e = 0; e < 8; ++e) y[e] = bf2f(tile[(cg * 8 + e) * 136 + rs * 4 + r]);
            u32x4 w; w.x = pk2(o[r][0] * y[0], o[r][1] * y[1]); w.y = pk2(o[r][2] * y[2], o[r][3] * y[3]); w.z = pk2(o[r][4] * y[4], o[r][5] * y[5]); w.w = pk2(o[r][6] * y[6], o[r][7] * y[7]);
            *(u32x4*)(YHY + ((size_t)b * SEQ + s0 + r) * DH + c0) = w; } };
    u32x4 ya[4], xa[6], yb[4], xb[6]; int u = vb;
    if (u < 2048) load_u(u, ya, xa);
    for (; u < 2048; u += 2 * G) {
        const bool h1 = u + G < 2048, h2 = u + 2 * G < 2048;
        if (h1) load_u(u + G, yb, xb);
        proc_u(u, ya, xa);
        if (h1) { if (h2) load_u(u + 2 * G, ya, xa); proc_u(u + G, yb, xb); }
    }
}
template <bool ROUTER>
__device__ __forceinline__ void ph_ln(KP p, const float* g, const float* b, bf16* Hout, LAS unsigned char* lds, int vb, int G, int wv) {
    const int tid = opaque_tid(wv), lane = tid & 63, wave = tid >> 6;
    const f32x4* g4 = (const f32x4*)g; const f32x4* b4 = (const f32x4*)b; const float* R = p->out;
    LAS float* rw = (LAS float*)lds;
    LAS int* lcnt = (LAS int*)(lds + 65536);
    LAS int* tinfo = (LAS int*)(lds + 65536 + 64);
    unsigned* ctl = (unsigned*)(p->ws + WS_CTL);
    unsigned* TE = (unsigned*)(p->ws + WS_TOK); float* TW = (float*)(TE + NT); int* TP = (int*)(TW + 2 * NT);
    if (ROUTER) { for (int i = tid; i < 2048 * 8; i += 512) rw[i] = p->in[23][i]; }
    for (int blk = vb; blk < NT / 128; blk += G) {
        if (ROUTER) { __syncthreads(); if (tid < 16) lcnt[tid] = 0; __syncthreads(); }
        for (int r = 0; r < 16; ++r) {
            const int lrow = wave * 16 + r; const int m = blk * 128 + lrow;
            const f32x4* xr = (const f32x4*)(R + (size_t)m * DM); f32x4 v[8];
#pragma unroll
            for (int j = 0; j < 8; ++j) v[j] = xr[lane + 64 * j];
            float mean, rstd; ln_row_stats(v, mean, rstd);
            u32x2* o = (u32x2*)(Hout + (size_t)m * DM); unsigned* o8 = (unsigned*)(p->ws + WS_HF8 + (size_t)m * DM);
#pragma unroll
            for (int j = 0; j < 8; ++j) { const f32x4 gg = g4[lane + 64 * j], bb = b4[lane + 64 * j]; v[j] = (v[j] - mean) * rstd * gg + bb;
                u32x2 w; w.x = pk2(v[j].x, v[j].y); w.y = pk2(v[j].z, v[j].w); o[lane + 64 * j] = w; o8[lane + 64 * j] = pk4_fp8(v[j].x, v[j].y, v[j].z, v[j].w); }
            if (ROUTER) {
                float lg[8];
#pragma unroll
                for (int e = 0; e < 8; ++e) lg[e] = 0.f;
#pragma unroll
                for (int j = 0; j < 8; ++j)
#pragma unroll
                    for (int i = 0; i < 4; ++i) { const int col = 4 * (lane + 64 * j) + i; const f32x4 wa = *(const LAS f32x4*)(rw + col * 8), wb = *(const LAS f32x4*)(rw + col * 8 + 4); const float x = v[j][i];
                        lg[0] += x * wa.x; lg[1] += x * wa.y; lg[2] += x * wa.z; lg[3] += x * wa.w; lg[4] += x * wb.x; lg[5] += x * wb.y; lg[6] += x * wb.z; lg[7] += x * wb.w; }
#pragma unroll
                for (int e = 0; e < 8; ++e) lg[e] = wave_sum(lg[e]) + p->in[24][e];
                int e1 = 0; float l1 = lg[0];
#pragma unroll
                for (int e = 1; e < 8; ++e) if (lg[e] > l1) { l1 = lg[e]; e1 = e; }
                int e2 = -1; float l2 = -3.0e38f;
#pragma unroll
                for (int e = 0; e < 8; ++e) if (e != e1 && lg[e] > l2) { l2 = lg[e]; e2 = e; }
                if (lane == 0) { const float w2 = 1.0f / (1.0f + expf(l1 - l2)); const float w1 = 1.0f - w2;
                    const int p1 = atomicAdd((int*)&lcnt[e1], 1), p2 = atomicAdd((int*)&lcnt[e2], 1);
                    tinfo[lrow * 4 + 0] = e1; tinfo[lrow * 4 + 1] = e2; tinfo[lrow * 4 + 2] = p1; tinfo[lrow * 4 + 3] = p2;
                    TW[2 * m] = w1; TW[2 * m + 1] = w2; }
            }
        }
        if (ROUTER) {
            __syncthreads();
            if (tid < 8) lcnt[8 + tid] = (int)atomicAdd(&ctl[CW_CNT + tid], (unsigned)lcnt[tid]);
            __syncthreads();
            if (tid < 128) { const int m = blk * 128 + tid; const int e1 = tinfo[tid * 4], e2 = tinfo[tid * 4 + 1];
                TE[m] = (unsigned)e1 | ((unsigned)e2 << 8); TP[2 * m] = lcnt[8 + e1] + tinfo[tid * 4 + 2]; TP[2 * m + 1] = lcnt[8 + e2] + tinfo[tid * 4 + 3]; }
        }
    }
}
__device__ __forceinline__ void ph_router(KP p, LAS unsigned char* lds, int vb, int G, int wv) {
    const int tid = opaque_tid(wv), lane = tid & 63, wave = tid >> 6;
    LAS float* rw = (LAS float*)lds;
    LAS int* lcnt = (LAS int*)(lds + 65536);
    LAS int* tinfo = (LAS int*)(lds + 65536 + 64);
    unsigned* ctl = (unsigned*)(p->ws + WS_CTL);
    unsigned* TE = (unsigned*)(p->ws + WS_TOK); float* TW = (float*)(TE + NT); int* TP = (int*)(TW + 2 * NT);
    const bf16* H1 = (const bf16*)(p->ws + WS_H1);
    for (int i = tid; i < 2048 * 8; i += 512) rw[i] = p->in[23][i];
    for (int blk = vb; blk < NT / 128; blk += G) {
        __syncthreads(); if (tid < 16) lcnt[tid] = 0; __syncthreads();
        for (int r4 = 0; r4 < 4; ++r4) {
            const int lrow0 = wave * 16 + r4 * 4; const int m0 = blk * 128 + lrow0;
            const u32x2* hp = (const u32x2*)(H1 + (size_t)m0 * DM) + lane;
            u32x2 cur[4], nxt[4];
#pragma unroll
            for (int rr = 0; rr < 4; ++rr) { cur[rr] = hp[rr * 512]; nxt[rr] = cur[rr]; }
            float lg[4][8];
#pragma unroll
            for (int rr = 0; rr < 4; ++rr)
#pragma unroll
                for (int e = 0; e < 8; ++e) lg[rr][e] = 0.f;
#pragma unroll 1
            for (int j = 0; j < 8; ++j) {
                if (j + 1 < 8) {
#pragma unroll
                    for (int rr = 0; rr < 4; ++rr) nxt[rr] = hp[rr * 512 + 64 * (j + 1)]; }
#pragma unroll
                for (int i = 0; i < 4; ++i) { const int col = 4 * (lane + 64 * j) + i; const f32x4 wa = *(const LAS f32x4*)(rw + col * 8), wb = *(const LAS f32x4*)(rw + col * 8 + 4);
#pragma unroll
                    for (int rr = 0; rr < 4; ++rr) { const unsigned w = (i < 2) ? cur[rr].x : cur[rr].y; const float x = (i & 1) ? bfhi(w) : bflo(w);
                        lg[rr][0] += x * wa.x; lg[rr][1] += x * wa.y; lg[rr][2] += x * wa.z; lg[rr][3] += x * wa.w; lg[rr][4] += x * wb.x; lg[rr][5] += x * wb.y; lg[rr][6] += x * wb.z; lg[rr][7] += x * wb.w; } }
#pragma unroll
                for (int rr = 0; rr < 4; ++rr) cur[rr] = nxt[rr];
            }
#pragma unroll
            for (int rr = 0; rr < 4; ++rr) {
                float l8[8];
#pragma unroll
                for (int e = 0; e < 8; ++e) l8[e] = wave_sum(lg[rr][e]) + p->in[24][e];
                int e1 = 0; float l1 = l8[0];
#pragma unroll
                for (int e = 1; e < 8; ++e) if (l8[e] > l1) { l1 = l8[e]; e1 = e; }
                int e2 = -1; float l2 = -3.0e38f;
#pragma unroll
                for (int e = 0; e < 8; ++e) if (e != e1 && l8[e] > l2) { l2 = l8[e]; e2 = e; }
                if (lane == 0) { const int lrow = lrow0 + rr, m = m0 + rr; const float w2 = 1.0f / (1.0f + expf(l1 - l2)); const float w1 = 1.0f - w2;
                    const int p1 = atomicAdd((int*)&lcnt[e1], 1), p2 = atomicAdd((int*)&lcnt[e2], 1);
                    tinfo[lrow * 4 + 0] = e1; tinfo[lrow * 4 + 1] = e2; tinfo[lrow * 4 + 2] = p1; tinfo[lrow * 4 + 3] = p2;
                    TW[2 * m] = w1; TW[2 * m + 1] = w2; }
            }
        }
        __syncthreads();
        if (tid < 8) lcnt[8 + tid] = (int)atomicAdd(&ctl[CW_CNT + tid], (unsigned)lcnt[tid]);
        __syncthreads();
        if (tid < 128) { const int m = blk * 128 + tid; const int e1 = tinfo[tid * 4], e2 = tinfo[tid * 4 + 1];
            TE[m] = (unsigned)e1 | ((unsigned)e2 << 8); TP[2 * m] = lcnt[8 + e1] + tinfo[tid * 4 + 2]; TP[2 * m + 1] = lcnt[8 + e2] + tinfo[tid * 4 + 3]; }
    }
}
__device__ __forceinline__ void ph_gather(KP p, int vb, int G, int wv) {
    const int tid = opaque_tid(wv), lane = tid & 63, wave = tid >> 6; const int gw = vb * 8 + wave, NGW = G * 8;
    unsigned* ctl = (unsigned*)(p->ws + WS_CTL);
    unsigned* TE = (unsigned*)(p->ws + WS_TOK); float* TW = (float*)(TE + NT); int* TP = (int*)(TW + 2 * NT);
    const bf16* H1 = (const bf16*)(p->ws + WS_H1); unsigned char* XG = p->ws + WS_XG;
    int cnt[8], tb[9]; tb[0] = 0;
#pragma unroll
    for (int e = 0; e < 8; ++e) { cnt[e] = (int)ctl[CW_CNT + e]; tb[e + 1] = tb[e] + (cnt[e] + 255) / 256; }
    if (vb == 0) {
        if (tid == 0) { ctl[CW_NTILES] = (unsigned)tb[8]; for (int e = 0; e < 9; ++e) ctl[CW_TBASE + e] = (unsigned)tb[e]; }
        for (int t = tid; t < MAXTILES; t += 512) { int e = 0;
#pragma unroll
            for (int q = 1; q < 8; ++q) if (t >= tb[q]) e = q;
            ctl[CW_TILE_E + t] = (unsigned)e; }
    }
    for (int m0 = gw; m0 < NT; m0 += 4 * NGW) {
        unsigned ee[4]; int pp1[4], pp2[4]; u32x4 w0[4], w1[4];
#pragma unroll
        for (int k = 0; k < 4; ++k) { const int m = m0 + k * NGW; const int mm = m < NT ? m : NT - 1; ee[k] = TE[mm]; pp1[k] = TP[2 * mm]; pp2[k] = TP[2 * mm + 1];
            const u32x4* src = (const u32x4*)(p->ws + WS_HF8 + (size_t)mm * DM); w0[k] = src[lane]; w1[k] = src[lane + 64]; }
#pragma unroll
        for (int k = 0; k < 4; ++k) { const int m = m0 + k * NGW; if (m < NT) {
            const int e1 = ee[k] & 255, e2 = (ee[k] >> 8) & 255; int b1 = 0, b2 = 0;
#pragma unroll
            for (int q = 0; q < 8; ++q) { if (e1 == q) b1 = tb[q]; if (e2 == q) b2 = tb[q]; }
            const int d1 = b1 * 256 + pp1[k], d2 = b2 * 256 + pp2[k];
            u32x4* q1 = (u32x4*)(XG + (size_t)d1 * DM); u32x4* q2 = (u32x4*)(XG + (size_t)d2 * DM);
            q1[lane] = w0[k]; q1[lane + 64] = w1[k]; q2[lane] = w0[k]; q2[lane + 64] = w1[k];
            if (lane == 0) { TP[2 * m] = d1; TP[2 * m + 1] = d2; } } }
    }
#pragma unroll
    for (int e = 0; e < 8; ++e) { const int r0 = tb[e] * 256 + cnt[e], r1 = tb[e + 1] * 256;
        for (int r = r0 + gw; r < r1; r += NGW) { u32x2* q = (u32x2*)(XG + (size_t)r * DM);
#pragma unroll
            for (int j = 0; j < 4; ++j) q[lane + 64 * j] = (u32x2){0u, 0u}; } }
}
__device__ __forceinline__ void ph_combine_ln(KP p, const float* g, const float* b, int vb, int G, int wv) {
    const int tid_ = opaque_tid(wv); const int lane = tid_ & 63, wave = tid_ >> 6; const int gw = vb * 8 + wave, NGW = G * 8;
    unsigned* TE = (unsigned*)(p->ws + WS_TOK); float* TW = (float*)(TE + NT); int* TP = (int*)(TW + 2 * NT);
    const bf16* H1 = (const bf16*)(p->ws + WS_H1); const bf16* YG = (const bf16*)(p->ws + WS_YG);
    const f32x4* g4 = (const f32x4*)g; const f32x4* b4 = (const f32x4*)b;
    float al = ALPHA; asm volatile("" : "+s"(al));
    for (int m0 = gw; m0 < NT; m0 += 2 * NGW) {
        float w1[2], w2[2]; int d1[2], d2[2]; u32x2 hh[2][8], ya[2][8], yc[2][8];
#pragma unroll
        for (int k = 0; k < 2; ++k) { const int m = m0 + k * NGW; const int mm = m < NT ? m : NT - 1; w1[k] = TW[2 * mm]; w2[k] = TW[2 * mm + 1]; d1[k] = TP[2 * mm]; d2[k] = TP[2 * mm + 1]; }
#pragma unroll
        for (int k = 0; k < 2; ++k) { const int m = m0 + k * NGW; const int mm = m < NT ? m : NT - 1;
            const u32x2* hr = (const u32x2*)(H1 + (size_t)mm * DM); const u32x2* y1 = (const u32x2*)(YG + (size_t)d1[k] * DM); const u32x2* y2 = (const u32x2*)(YG + (size_t)d2[k] * DM);
#pragma unroll
            for (int j = 0; j < 8; ++j) { hh[k][j] = hr[lane + 64 * j]; ya[k][j] = y1[lane + 64 * j]; yc[k][j] = y2[lane + 64 * j]; } }
#pragma unroll
        for (int k = 0; k < 2; ++k) { const int m = m0 + k * NGW; if (m < NT) {
            f32x4 v[8];
#pragma unroll
            for (int j = 0; j < 8; ++j) { const u32x2 h = hh[k][j], a = ya[k][j], c = yc[k][j];
                v[j].x = al * bflo(h.x) + w1[k] * bflo(a.x) + w2[k] * bflo(c.x); v[j].y = al * bfhi(h.x) + w1[k] * bfhi(a.x) + w2[k] * bfhi(c.x);
                v[j].z = al * bflo(h.y) + w1[k] * bflo(a.y) + w2[k] * bflo(c.y); v[j].w = al * bfhi(h.y) + w1[k] * bfhi(a.y) + w2[k] * bfhi(c.y); }
            float mean, rstd; ln_row_stats(v, mean, rstd);
            f32x4* o = (f32x4*)(p->out + (size_t)m * DM);
#pragma unroll
            for (int j = 0; j < 8; ++j) o[lane + 64 * j] = (v[j] - mean) * rstd * g4[lane + 64 * j] + b4[lane + 64 * j]; } }
    }
}


namespace pg8 {
constexpr int BM = 256, BK = 64, HALF = 128, HTB = HALF * BK * 2, STAGE_BYTES = 8 * HTB, NXCD = 8, WGM = 8;
__host__ __device__ __forceinline__ int lds_byte(int r, int c) { const int st = (r >> 4) * 2 + (c >> 5), rr = r & 15, cc = c & 31, ob = rr * 64 + cc * 2; return st * 1024 + (ob ^ (((ob >> 9) & 1) << 5)); }
__host__ __device__ __forceinline__ void stage_rc(int b, int& R, int& C) { const int st = b / 1024, sb = b % 1024, swz = sb ^ (((sb >> 9) & 1) << 5); R = (st >> 1) * 16 + swz / 64; C = (st & 1) * 32 + (swz % 64) / 2; }
__host__ __device__ __forceinline__ int perm32(int rho) { const int n = rho >> 4, i = rho & 15; return 8 * (i >> 2) + 4 * n + (i & 3); }

struct Unit { int pm, pn, om, on; };
struct Gemm { const void* A; const void* Bt; int lda, K; float cs = 1.0f; };

__device__ __forceinline__ void tile_map(int L, int nM, int nN, int& pm, int& pn) {
    const int nwg = nM * nN; int wgid = L; { const int q = nwg / NXCD, r = nwg % NXCD, xcd = wgid % NXCD, off = wgid / NXCD; wgid = (xcd < r ? xcd * (q + 1) : r * (q + 1) + (xcd - r) * q) + off; }
    const int nig = WGM * nN, gid = wgid / nig, fm = gid * WGM, gsz = (nM - fm) < WGM ? (nM - fm) : WGM;
    pm = fm + ((wgid % nig) % gsz); pn = (wgid % nig) / gsz;
}
struct StaticOrder {
    int nM, nN, G, c; int on0 = 0, skip_lo = 1 << 30, skip_n = 0;
    __device__ __forceinline__ bool next(int i, Unit& u) const { const int L = i * G + c; if (L >= nM * nN) return false; tile_map(L, nM, nN, u.pm, u.pn); if (u.pn >= skip_lo) u.pn += skip_n; u.om = u.pm; u.on = u.pn + on0; return true; }
};
struct PanelOrder {
    int nM, G, c;
    __device__ __forceinline__ bool next(int i, Unit& u) const { if (i * 32 >= nM) return false; const int j = c >> 3; u.pm = i * 32 + (c & 7) * 4 + (j & 3); u.pn = j >> 2; u.om = u.pm; u.on = u.pn; return true; }
};
struct GroupedOrder {
    int ntl, tile0, nN, G, c; const unsigned* tile_e; bool a_local;
    __device__ __forceinline__ bool next(int i, Unit& u) const { const int L = i * G + c; if (L >= ntl * nN) return false; int pm, pn; tile_map(L, ntl, nN, pm, pn);
        const int e = (int)tile_e[tile0 + pm]; u.pn = e * nN + pn; u.on = pn; u.pm = a_local ? pm : tile0 + pm; u.om = a_local ? tile0 + pm : pm; return true; }
};

__device__ __forceinline__ unsigned cvt_pk_bf16(float lo, float hi) { unsigned r; asm volatile("v_cvt_pk_bf16_f32 %0, %1, %2" : "=v"(r) : "v"(lo), "v"(hi)); return r; }
__device__ __forceinline__ float fast_sigmoid(float x) { return __builtin_amdgcn_rcpf(1.0f + __builtin_amdgcn_exp2f(-1.4426950408889634f * x)); }
#ifndef MK_EPI_PERM
#define MK_EPI_PERM 1
#endif
struct EpiLane { int prow, pchunk, pa; };
__device__ __forceinline__ EpiLane epi_lane(int fr, int fq) { EpiLane e; const int L = fr + 16 * fq;
    if (MK_EPI_PERM) { e.prow = L >> 2; e.pchunk = L & 3; e.pa = ((L >> 2) + 16 * (L & 3)) << 2; } else { e.prow = fr; e.pchunk = fq; e.pa = L << 2; } return e; }
__device__ __forceinline__ unsigned bperm(int pa, unsigned v) { return MK_EPI_PERM ? (unsigned)__builtin_amdgcn_ds_bpermute(pa, (int)v) : v; }
__device__ __forceinline__ float bpermf(int pa, float v) { return MK_EPI_PERM ? __int_as_float(__builtin_amdgcn_ds_bpermute(pa, __float_as_int(v))) : v; }
__device__ __forceinline__ u32x4 bperm4(int pa, u32x4 w) { u32x4 r; r.x = bperm(pa, w.x); r.y = bperm(pa, w.y); r.z = bperm(pa, w.z); r.w = bperm(pa, w.w); return r; }
struct EpiStore {
    static constexpr bool FUSED = false;
    static constexpr int NVM = 16;
    bf16* O; int ldc;
    __device__ __forceinline__ void operator()(const f32x4 (&acc)[2][2][4][2], const Unit& u, int wr, int wc, int fr, int fq) const {
        const EpiLane e = epi_lane(fr, fq); const int row0 = u.om * BM + wr * 64 + e.prow, col0 = u.on * BM + wc * 32 + 8 * e.pchunk;
#pragma unroll
        for (int ai = 0; ai < 2; ++ai)
#pragma unroll
            for (int m = 0; m < 4; ++m) { bf16* rowp = O + (size_t)(row0 + ai * HALF + m * 16) * ldc + col0;
#pragma unroll
                for (int bj = 0; bj < 2; ++bj) { const f32x4 v0 = acc[ai][bj][m][0], v1 = acc[ai][bj][m][1]; u32x4 w; w.x = cvt_pk_bf16(v0[0], v0[1]); w.y = cvt_pk_bf16(v0[2], v0[3]); w.z = cvt_pk_bf16(v1[0], v1[1]); w.w = cvt_pk_bf16(v1[2], v1[3]);
                    *(u32x4*)(rowp + bj * HALF) = bperm4(e.pa, w); } }
    }
};
template <bool ADD> struct EpiGate {
    static constexpr bool FUSED = false;
    static constexpr int NVM = ADD ? 48 : 32;
    const bf16* gate; int ldg; bf16* O; int ldc; unsigned char* O8 = nullptr;
    __device__ __forceinline__ void operator()(const f32x4 (&acc)[2][2][4][2], const Unit& u, int wr, int wc, int fr, int fq) const {
        const EpiLane e = epi_lane(fr, fq); const int row0 = u.om * BM + wr * 64 + e.prow, col0 = u.on * BM + wc * 32 + 8 * e.pchunk;
#pragma unroll
        for (int ai = 0; ai < 2; ++ai)
#pragma unroll
            for (int m = 0; m < 4; ++m) { const size_t r = (size_t)(row0 + ai * HALF + m * 16);
#pragma unroll
                for (int bj = 0; bj < 2; ++bj) { const u32x4 g = *(const u32x4*)(gate + r * ldg + col0 + bj * HALF); bf16* op = O + r * ldc + col0 + bj * HALF;
                    float a[8];
#pragma unroll
                    for (int q = 0; q < 4; ++q) { a[q] = bpermf(e.pa, acc[ai][bj][m][0][q]); a[4 + q] = bpermf(e.pa, acc[ai][bj][m][1][q]); }
                    float o[8];
                    o[0] = fast_sigmoid(bflo(g.x)) * a[0]; o[1] = fast_sigmoid(bfhi(g.x)) * a[1]; o[2] = fast_sigmoid(bflo(g.y)) * a[2]; o[3] = fast_sigmoid(bfhi(g.y)) * a[3];
                    o[4] = fast_sigmoid(bflo(g.z)) * a[4]; o[5] = fast_sigmoid(bfhi(g.z)) * a[5]; o[6] = fast_sigmoid(bflo(g.w)) * a[6]; o[7] = fast_sigmoid(bfhi(g.w)) * a[7];
                    if (ADD) { const u32x4 pv = *(const u32x4*)op; o[0] += bflo(pv.x); o[1] += bfhi(pv.x); o[2] += bflo(pv.y); o[3] += bfhi(pv.y); o[4] += bflo(pv.z); o[5] += bfhi(pv.z); o[6] += bflo(pv.w); o[7] += bfhi(pv.w); }
                    if (ADD && O8) { u32x2 w8; w8.x = pk4_fp8(o[0], o[1], o[2], o[3]); w8.y = pk4_fp8(o[4], o[5], o[6], o[7]); *(u32x2*)(O8 + r * DM + col0 + bj * HALF) = w8; }
                    else { u32x4 w; w.x = cvt_pk_bf16(o[0], o[1]); w.y = cvt_pk_bf16(o[2], o[3]); w.z = cvt_pk_bf16(o[4], o[5]); w.w = cvt_pk_bf16(o[6], o[7]);
                    *(u32x4*)op = w; } } }
    }
};
struct EpiRes {
    static constexpr bool FUSED = false;
    static constexpr int NVM = 48;
    const bf16* res; float* R; float s, al;
    __device__ __forceinline__ void operator()(const f32x4 (&acc)[2][2][4][2], const Unit& u, int wr, int wc, int fr, int fq) const {
        const EpiLane e = epi_lane(fr, fq); const int row0 = u.om * BM + wr * 64 + e.prow, col0 = u.on * BM + wc * 32 + 8 * e.pchunk;
#pragma unroll
        for (int ai = 0; ai < 2; ++ai)
#pragma unroll
            for (int m = 0; m < 4; ++m) { const size_t r = (size_t)(row0 + ai * HALF + m * 16);
#pragma unroll
                for (int bj = 0; bj < 2; ++bj) { const u32x4 h = *(const u32x4*)(res + r * DM + col0 + bj * HALF); float* op = R + r * DM + col0 + bj * HALF;
                    float a[8];
#pragma unroll
                    for (int q = 0; q < 4; ++q) { a[q] = bpermf(e.pa, acc[ai][bj][m][0][q]) * s; a[4 + q] = bpermf(e.pa, acc[ai][bj][m][1][q]) * s; }
                    *(f32x4*)op = (f32x4){al * bflo(h.x) + a[0], al * bfhi(h.x) + a[1], al * bflo(h.y) + a[2], al * bfhi(h.y) + a[3]};
                    *(f32x4*)(op + 4) = (f32x4){al * bflo(h.z) + a[4], al * bfhi(h.z) + a[5], al * bflo(h.w) + a[6], al * bfhi(h.w) + a[7]}; } }
    }
};
__device__ __forceinline__ f32x2 swiglu_pk(f32x2 ag, f32x2 au, float c1  , float s2  ) {
    const f32x2 x = ag * c1, t = (ag * s2) * au;
    f32x2 e; e.x = __builtin_amdgcn_exp2f(x.x); e.y = __builtin_amdgcn_exp2f(x.y);
    const f32x2 d = e + 1.0f;
    f32x2 r; r.x = __builtin_amdgcn_rcpf(d.x); r.y = __builtin_amdgcn_rcpf(d.y);
    return t * r;
}
struct EpiSwiglu {
    static constexpr bool FUSED = false;
    static constexpr int NVM = 8;
    bf16* O; int ldc;
    __device__ __forceinline__ void operator()(const f32x4 (&acc)[2][2][4][2], const Unit& u, int wr, int wc, int fr, int fq) const {
        const EpiLane e = epi_lane(fr, fq); const int row0 = u.om * BM + wr * 64 + e.prow, col0 = u.on * HALF + wc * 32 + 8 * e.pchunk;
#pragma unroll
        for (int ai = 0; ai < 2; ++ai)
#pragma unroll
            for (int m = 0; m < 4; ++m) { float o[8];
#pragma unroll
                for (int n = 0; n < 2; ++n)
#pragma unroll
                    for (int q = 0; q < 4; q += 2) { const f32x4 g = acc[ai][0][m][n], up = acc[ai][1][m][n]; const f32x2 r = swiglu_pk((f32x2){g[q], g[q + 1]}, (f32x2){up[q], up[q + 1]}, -1.4426950408889634f, 1.0f); o[4 * n + q] = r.x; o[4 * n + q + 1] = r.y; }
                u32x4 w; w.x = cvt_pk_bf16(o[0], o[1]); w.y = cvt_pk_bf16(o[2], o[3]); w.z = cvt_pk_bf16(o[4], o[5]); w.w = cvt_pk_bf16(o[6], o[7]);
                *(u32x4*)(O + (size_t)(row0 + ai * HALF + m * 16) * ldc + col0) = bperm4(e.pa, w); }
    }
};

#ifndef MK_STAGE_ASM
#define MK_STAGE_ASM 1
#endif
#ifndef MK_KROT
#define MK_KROT 0
#endif
#ifndef MK_LN_FUSE
#define MK_LN_FUSE 1
#endif
#ifndef MK_RELAX_WAIT
#define MK_RELAX_WAIT 1
#endif
__device__ __forceinline__ void glds_saddr(const void* sbase, unsigned voff, unsigned ldsdst) { unsigned keep;
    asm volatile("s_mov_b32 %0, m0\n\ts_mov_b32 m0, %3\n\ts_nop 0\n\tglobal_load_lds_dwordx4 %1, %2\n\ts_mov_b32 m0, %0" : "=&s"(keep) : "v"(voff), "s"(sbase), "s"(ldsdst) : "memory"); }
typedef int i32x8 __attribute__((ext_vector_type(8)));
typedef int i32x4 __attribute__((ext_vector_type(4)));
__device__ __forceinline__ i32x8 cat8(bf16x8 a, bf16x8 b) { const i32x4 x = __builtin_bit_cast(i32x4, a), y = __builtin_bit_cast(i32x4, b); return __builtin_shufflevector(x, y, 0, 1, 2, 3, 4, 5, 6, 7); }
struct EpiGateQ {
    static constexpr bool FUSED = true;
    static constexpr int NVM = 16;
    const bf16* gate; int ldg; const bf16* prev; int ldp; unsigned char* O8; float* sa; unsigned* xb; unsigned* cnt; unsigned* tmo;
    __device__ __forceinline__ void fused(f32x4 (&acc)[2][2][4][2], const Unit& u, int wr, int wc, int fr, int fq, LAS unsigned char* tab, int wid) const {
        LAS float* P = (LAS float*)tab;
        LAS float* S = (LAS float*)(tab + 4096);
        const EpiLane e = epi_lane(fr, fq); const int lane = fr + 16 * fq;
        const int rowl0 = wr * 64 + e.prow, col0 = u.on * BM + wc * 32 + 8 * e.pchunk;
        unsigned go = (unsigned)(((u.om * BM + rowl0) * ldg + col0) * 2); asm volatile("" : "+v"(go));
#pragma unroll
        for (int ai = 0; ai < 2; ++ai) { u32x4 gq[4][2], pq[4][2];
#pragma unroll
            for (int m = 0; m < 4; ++m)
#pragma unroll
                for (int bj = 0; bj < 2; ++bj) { const unsigned o2 = go + (unsigned)(((ai * HALF + m * 16) * ldg + bj * HALF) * 2); gq[m][bj] = *(const u32x4*)((const char*)gate + o2); pq[m][bj] = *(const u32x4*)((const char*)prev + o2); }
            __builtin_amdgcn_sched_barrier(0);
#pragma unroll
            for (int m = 0; m < 4; ++m) {
#pragma unroll
                for (int bj = 0; bj < 2; ++bj) { const u32x4 g = gq[m][bj], pv = pq[m][bj]; float a[8];
#pragma unroll
                    for (int q = 0; q < 4; ++q) { a[q] = bpermf(e.pa, acc[ai][bj][m][0][q]); a[4 + q] = bpermf(e.pa, acc[ai][bj][m][1][q]); }
                    acc[ai][bj][m][0] = (f32x4){fast_sigmoid(bflo(g.x)) * a[0] + bflo(pv.x), fast_sigmoid(bfhi(g.x)) * a[1] + bfhi(pv.x), fast_sigmoid(bflo(g.y)) * a[2] + bflo(pv.y), fast_sigmoid(bfhi(g.y)) * a[3] + bfhi(pv.y)};
                    acc[ai][bj][m][1] = (f32x4){fast_sigmoid(bflo(g.z)) * a[4] + bflo(pv.z), fast_sigmoid(bfhi(g.z)) * a[5] + bfhi(pv.z), fast_sigmoid(bflo(g.w)) * a[6] + bflo(pv.w), fast_sigmoid(bfhi(g.w)) * a[7] + bfhi(pv.w)}; } }
            { float tie = acc[ai][1][3][1][3]; asm volatile("" : "+v"(go), "+v"(tie)); acc[ai][1][3][1][3] = tie; }
            __builtin_amdgcn_sched_barrier(0); }
#pragma unroll
        for (int ai = 0; ai < 2; ++ai)
#pragma unroll
            for (int m = 0; m < 4; ++m) { float mx = 0.f;
#pragma unroll
                for (int bj = 0; bj < 2; ++bj)
#pragma unroll
                    for (int n = 0; n < 2; ++n) { const f32x4 x = acc[ai][bj][m][n]; mx = fmaxf(mx, fmaxf(fmaxf(fabsf(x[0]), fabsf(x[1])), fmaxf(fabsf(x[2]), fabsf(x[3])))); }
                mx = fmaxf(mx, swz_xor<1>(mx)); mx = fmaxf(mx, swz_xor<2>(mx));
                P[(rowl0 + ai * HALF + m * 16) * 4 + wc] = mx; }
        asm volatile("s_waitcnt lgkmcnt(0)" ::: "memory"); __builtin_amdgcn_s_barrier(); asm volatile("" ::: "memory");
        const int row = wid * 32 + (lane & 31);
        if (lane < 32) { const float tm = fmaxf(fmaxf(P[row * 4 + 0], P[row * 4 + 1]), fmaxf(P[row * 4 + 2], P[row * 4 + 3]));
            __hip_atomic_store(xb + ((size_t)(u.om * BM + row) * 8 + u.on), __float_as_uint(tm), __ATOMIC_RELAXED, __HIP_MEMORY_SCOPE_AGENT); }
        asm volatile("s_waitcnt vmcnt(0)" ::: "memory");
        if (lane == 0) __hip_atomic_fetch_add(cnt + 64 * u.om, 1u, __ATOMIC_RELAXED, __HIP_MEMORY_SCOPE_AGENT);
        if (wid == 0) {
            unsigned spins = 0;
            while ((unsigned)__builtin_amdgcn_readfirstlane((int)__hip_atomic_load(cnt + 64 * u.om, __ATOMIC_RELAXED, __HIP_MEMORY_SCOPE_AGENT)) < 64u) {
                __builtin_amdgcn_s_sleep(1);
                if ((++spins & 255u) == 0u) { if (__hip_atomic_load(tmo, __ATOMIC_RELAXED, __HIP_MEMORY_SCOPE_AGENT) != 0u) break;
                    if (spins > (1u << 20)) { if (lane == 0) __hip_atomic_store(tmo, 1u, __ATOMIC_RELAXED, __HIP_MEMORY_SCOPE_AGENT); break; } } }
            __builtin_amdgcn_fence(__ATOMIC_ACQUIRE, "agent");
        }
        asm volatile("s_waitcnt vmcnt(0) lgkmcnt(0)" ::: "memory"); __builtin_amdgcn_s_barrier(); asm volatile("" ::: "memory");
        if (lane < 32) { const unsigned* slot = xb + (size_t)(u.om * BM + row) * 8; float mx = 1e-30f;
#pragma unroll
            for (int k = 0; k < 8; ++k) mx = fmaxf(mx, __uint_as_float(__hip_atomic_load(slot + k, __ATOMIC_RELAXED, __HIP_MEMORY_SCOPE_AGENT)));
            S[row] = 127.0f / mx; if (u.on == 0) sa[u.om * BM + row] = mx * (1.0f / 127.0f); }
        asm volatile("s_waitcnt lgkmcnt(0)" ::: "memory"); __builtin_amdgcn_s_barrier(); asm volatile("" ::: "memory");
        unsigned eo = (unsigned)((u.om * BM + rowl0) * DM + col0); asm volatile("" : "+v"(eo));
#pragma unroll
        for (int bj = 0; bj < 2; ++bj)
#pragma unroll
            for (int ai = 0; ai < 2; ++ai)
#pragma unroll
                for (int m = 0; m < 4; ++m) { const float q = S[rowl0 + ai * HALF + m * 16]; const f32x4 y0 = acc[ai][bj][m][0], y1 = acc[ai][bj][m][1];
                    u32x2 w8; w8.x = pk4_i8(y0[0], y0[1], y0[2], y0[3], q); w8.y = pk4_i8(y1[0], y1[1], y1[2], y1[3], q);
                    *(u32x2*)(O8 + (eo + (unsigned)((ai * HALF + m * 16) * DM + bj * HALF))) = w8; }
    }
};
struct EpiSwigluF8 {
    static constexpr bool FUSED = false;
    static constexpr int NVM = 8;
    unsigned char* O; int ldc; float s;
    __device__ __forceinline__ void operator()(const f32x4 (&acc)[2][2][4][2], const Unit& u, int wr, int wc, int fr, int fq) const {
        const EpiLane e = epi_lane(fr, fq); const int row0 = u.om * BM + wr * 64 + e.prow, col0 = u.on * HALF + wc * 32 + 8 * e.pchunk;
#pragma unroll
        for (int ai = 0; ai < 2; ++ai)
#pragma unroll
            for (int m = 0; m < 4; ++m) { float o[8];
#pragma unroll
                for (int n = 0; n < 2; ++n)
#pragma unroll
                    for (int q = 0; q < 4; q += 2) { const f32x4 g = acc[ai][0][m][n], up = acc[ai][1][m][n]; const f32x2 r = swiglu_pk((f32x2){g[q], g[q + 1]}, (f32x2){up[q], up[q + 1]}, -1.4426950408889634f * s, s * s); o[4 * n + q] = r.x; o[4 * n + q + 1] = r.y; }
                u32x2 w; w.x = bperm(e.pa, pk4_fp8(o[0], o[1], o[2], o[3])); w.y = bperm(e.pa, pk4_fp8(o[4], o[5], o[6], o[7]));
                *(u32x2*)(O + (size_t)(row0 + ai * HALF + m * 16) * ldc + col0) = w; }
    }
};
struct EpiStoreScaled {
    static constexpr bool FUSED = false;
    static constexpr int NVM = 16;
    bf16* O; int ldc; float s;
    __device__ __forceinline__ void operator()(const f32x4 (&acc)[2][2][4][2], const Unit& u, int wr, int wc, int fr, int fq) const {
        const EpiLane e = epi_lane(fr, fq); const int row0 = u.om * BM + wr * 64 + e.prow, col0 = u.on * BM + wc * 32 + 8 * e.pchunk;
#pragma unroll
        for (int ai = 0; ai < 2; ++ai)
#pragma unroll
            for (int m = 0; m < 4; ++m) { bf16* rowp = O + (size_t)(row0 + ai * HALF + m * 16) * ldc + col0;
#pragma unroll
                for (int bj = 0; bj < 2; ++bj) { const f32x4 v0 = acc[ai][bj][m][0] * s, v1 = acc[ai][bj][m][1] * s; u32x4 w; w.x = cvt_pk_bf16(v0[0], v0[1]); w.y = cvt_pk_bf16(v0[2], v0[3]); w.z = cvt_pk_bf16(v1[0], v1[1]); w.w = cvt_pk_bf16(v1[2], v1[3]);
                    *(u32x4*)(rowp + bj * HALF) = bperm4(e.pa, w); } }
    }
};

struct EpiProj {
    static constexpr bool FUSED = false;
    static constexpr int NVM = 16;
    bf16* O; int ldc; const float* qg; const float* kg; const float* ct; const float* st;
    __device__ __forceinline__ void operator()(const f32x4 (&acc)[2][2][4][2], const Unit& u, int wr, int wc, int fr, int fq) const {
        const EpiLane e = epi_lane(fr, fq);
        if (u.on < O_Q / BM || u.on >= O_V / BM) {
            const int row0 = u.om * BM + wr * 64 + e.prow, col0 = u.on * BM + wc * 32 + 8 * e.pchunk;
#pragma unroll
            for (int ai = 0; ai < 2; ++ai)
#pragma unroll
                for (int m = 0; m < 4; ++m) { bf16* rowp = O + (size_t)(row0 + ai * HALF + m * 16) * ldc + col0;
#pragma unroll
                    for (int bj = 0; bj < 2; ++bj) { const f32x4 v0 = acc[ai][bj][m][0], v1 = acc[ai][bj][m][1]; u32x4 w; w.x = cvt_pk_bf16(v0[0], v0[1]); w.y = cvt_pk_bf16(v0[2], v0[3]); w.z = cvt_pk_bf16(v1[0], v1[1]); w.w = cvt_pk_bf16(v1[2], v1[3]);
                        *(u32x4*)(rowp + bj * HALF) = bperm4(e.pa, w); } }
            return;
        }
        const bool isq = u.on < O_K / BM; const float* gg = isq ? qg : kg; const float sc = isq ? QSCALE : 1.0f;
        const int d0 = 8 * e.pchunk;
        const f32x4 ga0 = *(const f32x4*)(gg + d0), ga1 = *(const f32x4*)(gg + d0 + 4), gb0 = *(const f32x4*)(gg + 32 + d0), gb1 = *(const f32x4*)(gg + 32 + d0 + 4);
        const int row0 = u.om * BM + wr * 64 + e.prow, col0 = u.on * BM + wc * 64 + d0;
#pragma unroll
        for (int ai = 0; ai < 2; ++ai)
#pragma unroll
            for (int m = 0; m < 4; ++m) { const int row = row0 + ai * HALF + m * 16; const int pos = row & (SEQ - 1);
                f32x4 x0, x1, y0, y1;
#pragma unroll
                for (int q = 0; q < 4; ++q) { x0[q] = bpermf(e.pa, acc[ai][0][m][0][q]); x1[q] = bpermf(e.pa, acc[ai][0][m][1][q]); y0[q] = bpermf(e.pa, acc[ai][1][m][0][q]); y1[q] = bpermf(e.pa, acc[ai][1][m][1][q]); }
                const f32x4 c0 = *(const f32x4*)(ct + pos * 32 + d0), c1 = *(const f32x4*)(ct + pos * 32 + d0 + 4), s0 = *(const f32x4*)(st + pos * 32 + d0), s1 = *(const f32x4*)(st + pos * 32 + d0 + 4);
                float ss = 0.f;
#pragma unroll
                for (int q = 0; q < 4; ++q) ss += x0[q] * x0[q] + x1[q] * x1[q] + y0[q] * y0[q] + y1[q] * y1[q];
                ss += swz_xor<1>(ss); ss += swz_xor<2>(ss);
                const float rinv = 1.0f / sqrtf(ss * (1.0f / 64.0f) + RMS_EPS);
                x0 = x0 * rinv * ga0; x1 = x1 * rinv * ga1; y0 = y0 * rinv * gb0; y1 = y1 * rinv * gb1;
                const f32x4 o0 = (x0 * c0 - y0 * s0) * sc, o1 = (x1 * c1 - y1 * s1) * sc, p0 = (y0 * c0 + x0 * s0) * sc, p1 = (y1 * c1 + x1 * s1) * sc;
                bf16* rowp = O + (size_t)row * ldc + col0;
                u32x4 w; w.x = cvt_pk_bf16(o0[0], o0[1]); w.y = cvt_pk_bf16(o0[2], o0[3]); w.z = cvt_pk_bf16(o1[0], o1[1]); w.w = cvt_pk_bf16(o1[2], o1[3]);
                *(u32x4*)rowp = w;
                w.x = cvt_pk_bf16(p0[0], p0[1]); w.y = cvt_pk_bf16(p0[2], p0[3]); w.z = cvt_pk_bf16(p1[0], p1[1]); w.w = cvt_pk_bf16(p1[2], p1[3]);
                *(u32x4*)(rowp + 32) = w; }
    }
};

struct EpiResLn {
    static constexpr bool FUSED = true;
    static constexpr int NVM = 16;
    const bf16* res; bf16* H; unsigned char* H8; const float* g; const float* b; float s, al; unsigned long long* xbuf; unsigned* cnt; unsigned* tmo; float q8 = 0.f; const float* sa = nullptr;
    __device__ __forceinline__ void fused(f32x4 (&acc)[2][2][4][2], const Unit& u, int wr, int wc, int fr, int fq, LAS unsigned char* tab, int wid) const {
        typedef float f32x2v __attribute__((ext_vector_type(2)));
        LAS f32x2v* P = (LAS f32x2v*)tab;
        LAS f32x2v* S = (LAS f32x2v*)(tab + 8192);
        const EpiLane e = epi_lane(fr, fq); const int lane = fr + 16 * fq;
        const int rowl0 = wr * 64 + e.prow, col0 = u.on * BM + wc * 32 + 8 * e.pchunk;
        const unsigned eoff = (unsigned)(((u.om * BM + rowl0) * DM + col0) * 2);
#pragma unroll
        for (int ai = 0; ai < 2; ++ai)
#pragma unroll
            for (int m = 0; m < 4; ++m) { const float sr = sa ? s * sa[u.om * BM + rowl0 + ai * HALF + m * 16] : s;
#pragma unroll
                for (int bj = 0; bj < 2; ++bj) { const u32x4 hh = *(const u32x4*)((const char*)res + (eoff + (unsigned)(((ai * HALF + m * 16) * DM + bj * HALF) * 2))); f32x4 a0, a1;
#pragma unroll
                    for (int q = 0; q < 4; ++q) { a0[q] = bpermf(e.pa, acc[ai][bj][m][0][q]) * sr; a1[q] = bpermf(e.pa, acc[ai][bj][m][1][q]) * sr; }
                    acc[ai][bj][m][0] = (f32x4){al * bflo(hh.x) + a0[0], al * bfhi(hh.x) + a0[1], al * bflo(hh.y) + a0[2], al * bfhi(hh.y) + a0[3]};
                    acc[ai][bj][m][1] = (f32x4){al * bflo(hh.z) + a1[0], al * bfhi(hh.z) + a1[1], al * bflo(hh.w) + a1[2], al * bfhi(hh.w) + a1[3]}; } }
#pragma unroll
        for (int ai = 0; ai < 2; ++ai)
#pragma unroll
            for (int m = 0; m < 4; ++m) { float sm = 0.f;
#pragma unroll
                for (int bj = 0; bj < 2; ++bj)
#pragma unroll
                    for (int n = 0; n < 2; ++n) { const f32x4 x = acc[ai][bj][m][n]; sm += (x[0] + x[1]) + (x[2] + x[3]); }
                sm += swz_xor<1>(sm); sm += swz_xor<2>(sm);
                const float mw = sm * (1.0f / 64.0f); float q2 = 0.f;
#pragma unroll
                for (int bj = 0; bj < 2; ++bj)
#pragma unroll
                    for (int n = 0; n < 2; ++n) { const f32x4 d = acc[ai][bj][m][n] - mw; q2 += (d[0] * d[0] + d[1] * d[1]) + (d[2] * d[2] + d[3] * d[3]); }
                q2 += swz_xor<1>(q2); q2 += swz_xor<2>(q2);
                if (e.pchunk == 0) P[(rowl0 + ai * HALF + m * 16) * 4 + wc] = (f32x2v){mw, q2}; }
        asm volatile("s_waitcnt lgkmcnt(0)" ::: "memory"); __builtin_amdgcn_s_barrier(); asm volatile("" ::: "memory");
        const int row = wid * 32 + (lane & 31);
        if (lane < 32) {
            const f32x2v a = P[row * 4 + 0], bq = P[row * 4 + 1], c = P[row * 4 + 2], d = P[row * 4 + 3];
            const float mt = (a.x + bq.x + c.x + d.x) * 0.25f; const float da = a.x - mt, db = bq.x - mt, dc = c.x - mt, dd = d.x - mt;
            const float m2 = (a.y + bq.y) + (c.y + d.y) + 64.0f * ((da * da + db * db) + (dc * dc + dd * dd));
            __hip_atomic_store(xbuf + ((size_t)(u.om * BM + row) * 8 + u.on), ((unsigned long long)__float_as_uint(m2) << 32) | __float_as_uint(mt), __ATOMIC_RELAXED, __HIP_MEMORY_SCOPE_AGENT);
        }
        asm volatile("s_waitcnt vmcnt(0)" ::: "memory");
        if (lane == 0) __hip_atomic_fetch_add(cnt + 64 * u.om, 1u, __ATOMIC_RELAXED, __HIP_MEMORY_SCOPE_AGENT);
        if (wid == 0) {
            unsigned spins = 0;
            while ((unsigned)__builtin_amdgcn_readfirstlane((int)__hip_atomic_load(cnt + 64 * u.om, __ATOMIC_RELAXED, __HIP_MEMORY_SCOPE_AGENT)) < 64u) {
                __builtin_amdgcn_s_sleep(1);
                if ((++spins & 255u) == 0u) { if (__hip_atomic_load(tmo, __ATOMIC_RELAXED, __HIP_MEMORY_SCOPE_AGENT) != 0u) break;
                    if (spins > (1u << 20)) { if (lane == 0) __hip_atomic_store(tmo, 1u, __ATOMIC_RELAXED, __HIP_MEMORY_SCOPE_AGENT); break; } } }
            __builtin_amdgcn_fence(__ATOMIC_ACQUIRE, "agent");
        }
        asm volatile("s_waitcnt vmcnt(0) lgkmcnt(0)" ::: "memory"); __builtin_amdgcn_s_barrier(); asm volatile("" ::: "memory");
        if (lane < 32) {
            const unsigned long long* slot = xbuf + (size_t)(u.om * BM + row) * 8; float mt[8], m2[8]; float ms = 0.f;
#pragma unroll
            for (int k = 0; k < 8; ++k) { const unsigned long long w = __hip_atomic_load(slot + k, __ATOMIC_RELAXED, __HIP_MEMORY_SCOPE_AGENT); mt[k] = __uint_as_float((unsigned)w); m2[k] = __uint_as_float((unsigned)(w >> 32)); ms += mt[k]; }
            const float mean = ms * 0.125f; float q = 0.f;
#pragma unroll
            for (int k = 0; k < 8; ++k) { const float dm = mt[k] - mean; q += m2[k] + 256.0f * dm * dm; }
            S[row] = (f32x2v){mean, 1.0f / sqrtf(q * (1.0f / 2048.0f) + LN_EPS)};
        }
        asm volatile("s_waitcnt lgkmcnt(0)" ::: "memory"); __builtin_amdgcn_s_barrier(); asm volatile("" ::: "memory");
        unsigned eoff2 = eoff, coff = (unsigned)col0 * 4u; asm volatile("" : "+v"(eoff2), "+v"(coff));
#pragma unroll
        for (int bj = 0; bj < 2; ++bj) {
            const f32x4 g0 = *(const f32x4*)((const char*)g + (coff + bj * HALF * 4)), g1 = *(const f32x4*)((const char*)g + (coff + bj * HALF * 4 + 16)), b0 = *(const f32x4*)((const char*)b + (coff + bj * HALF * 4)), b1 = *(const f32x4*)((const char*)b + (coff + bj * HALF * 4 + 16));
#pragma unroll
            for (int ai = 0; ai < 2; ++ai)
#pragma unroll
                for (int m = 0; m < 4; ++m) { const int rl = rowl0 + ai * HALF + m * 16; const f32x2v sr = S[rl]; const unsigned o2 = eoff2 + (unsigned)(((ai * HALF + m * 16) * DM + bj * HALF) * 2);
                    const f32x4 y0 = (acc[ai][bj][m][0] - sr.x) * sr.y * g0 + b0, y1 = (acc[ai][bj][m][1] - sr.x) * sr.y * g1 + b1;
                    u32x4 w; w.x = cvt_pk_bf16(y0[0], y0[1]); w.y = cvt_pk_bf16(y0[2], y0[3]); w.z = cvt_pk_bf16(y1[0], y1[1]); w.w = cvt_pk_bf16(y1[2], y1[3]);
                    *(u32x4*)((char*)H + o2) = w;
                    if (H8) { u32x2 w8; if (q8 != 0.f) { w8.x = pk4_i8(y0[0], y0[1], y0[2], y0[3], q8); w8.y = pk4_i8(y1[0], y1[1], y1[2], y1[3], q8); } else { w8.x = pk4_fp8(y0[0], y0[1], y0[2], y0[3]); w8.y = pk4_fp8(y1[0], y1[1], y1[2], y1[3]); } *(u32x2*)(H8 + (o2 >> 1)) = w8; } }
        }
    }
};

template <class Epi, class Sched, bool ALIGN_EPI, bool SP2, int EB = 2, bool I8 = false>
__device__ __forceinline__ void gemm_phase(LAS unsigned char* lds, const Gemm g, const Sched& S, const Epi& E, int wv) {
    const int tid = opaque_tid(wv),
        wid = __builtin_amdgcn_readfirstlane(tid >> 6), lane = tid & 63, wr = wid >> 2, wc = wid & 3, fr = lane & 15, fq = lane >> 4;
    const int K = g.K * EB, nt = K / (BK * 2), lda = g.lda * EB;
    unsigned voffA[2], voffB[2];
#pragma unroll
    for (int i = 0; i < 2; ++i) { int R, C; stage_rc(tid * 16 + i * 8192, R, C); const int Rb = (R & ~31) + perm32(R & 31);
        voffA[i] = (unsigned)(R * lda + C * 2); voffB[i] = (unsigned)(Rb * K + C * 2); }
    const size_t kstep = (size_t)(BK * 2);
    const int rot = MK_KROT ? 2 * (((S.c >> 3) + (S.c >> 6)) % (nt / 2)) : 0;
#define PG8_KOFF(tt) ((size_t)(((tt) + rot) >= nt ? ((tt) + rot - nt) : ((tt) + rot)) * kstep)
    const size_t hstepA = (size_t)HALF * lda, hstepB = (size_t)HALF * K;
    const size_t tstepA = 2 * hstepA, tstepB = 2 * hstepB;
    const unsigned ldsw = (unsigned)wid * 1024u;
    const unsigned lds_u = (unsigned)(uintptr_t)lds; (void)lds_u;
    const int aoff = lds_byte(wr * 64 + fr, fq * 8), boff = lds_byte(wc * 32 + fr, fq * 8);
#define PG8_SA(b, h) (((b) * 2 + (h)) * HTB)
#define PG8_SB(b, h) ((4 + (b) * 2 + (h)) * HTB)
#if MK_STAGE_ASM
#define PG8_STAGE(bufoff, gbase, voff) do { _Pragma("unroll") for (int _i = 0; _i < 2; ++_i) \
        glds_saddr((const void*)(gbase), (voff)[_i], (unsigned)__builtin_amdgcn_readfirstlane((int)(lds_u + (unsigned)(bufoff) + ldsw + _i * 8192))); } while (0)
#else
#define PG8_STAGE(bufoff, gbase, voff) do { _Pragma("unroll") for (int _i = 0; _i < 2; ++_i) \
        __builtin_amdgcn_global_load_lds((const unsigned*)((const char*)(gbase) + (voff)[_i]), (LAS unsigned*)(lds + (bufoff) + ldsw + _i * 8192), 16, 0, 0); } while (0)
#endif
#define PG8_LDA(dst, b, h) do { _Pragma("unroll") for (int m = 0; m < 4; ++m) _Pragma("unroll") for (int k = 0; k < 2; ++k) dst[m][k] = *(const LAS bf16x8*)(lds + PG8_SA(b, h) + aoff + m * 2048 + k * 1024); } while (0)
#define PG8_LDB(dst, b, h) do { _Pragma("unroll") for (int n = 0; n < 2; ++n) _Pragma("unroll") for (int k = 0; k < 2; ++k) dst[n][k] = *(const LAS bf16x8*)(lds + PG8_SB(b, h) + boff + n * 2048 + k * 1024); } while (0)
#define PG8_MMA(ai, bj, At, Bt) do { __builtin_amdgcn_s_setprio(1); _Pragma("unroll") for (int m = 0; m < 4; ++m) _Pragma("unroll") for (int n = 0; n < 2; ++n) { \
        if constexpr (EB == 2) { _Pragma("unroll") for (int k = 0; k < 2; ++k) acc[ai][bj][m][n] = __builtin_amdgcn_mfma_f32_16x16x32_bf16(Bt[n][k], At[m][k], acc[ai][bj][m][n], 0, 0, 0); } \
        else if constexpr (I8) { _Pragma("unroll") for (int k = 0; k < 2; ++k) acc[ai][bj][m][n] = __builtin_bit_cast(f32x4, __builtin_amdgcn_mfma_i32_16x16x64_i8(__builtin_bit_cast(i32x4, Bt[n][k]), __builtin_bit_cast(i32x4, At[m][k]), __builtin_bit_cast(i32x4, acc[ai][bj][m][n]), 0, 0, 0)); }   \
        else acc[ai][bj][m][n] = __builtin_amdgcn_mfma_scale_f32_16x16x128_f8f6f4(cat8(Bt[n][0], Bt[n][1]), cat8(At[m][0], At[m][1]), acc[ai][bj][m][n], 0, 0, 0, 0, 0, 0); }   \
        __builtin_amdgcn_s_setprio(0); } while (0)
#define PG8_WAIT_V(n) asm volatile("s_waitcnt vmcnt(" #n ")" ::: "memory")
#define PG8_WAIT_L(n) asm volatile("s_waitcnt lgkmcnt(" #n ")" ::: "memory")
#define PG8_BAR __builtin_amdgcn_s_barrier()
#define PG8_SCHED __builtin_amdgcn_sched_barrier(0)
    Unit cur, nxt; int ui = 0;
    if (!S.next(0, cur)) return;
    f32x4 acc[2][2][4][2];
#pragma unroll
    for (int a = 0; a < 2; ++a)
#pragma unroll
        for (int b = 0; b < 2; ++b)
#pragma unroll
            for (int m = 0; m < 4; ++m)
#pragma unroll
                for (int n = 0; n < 2; ++n) acc[a][b][m][n] = (f32x4){0.f, 0.f, 0.f, 0.f};
    bf16x8 At[4][2], B0[2][2], B1[2][2];
    const char* cA = (const char*)g.A + (size_t)cur.pm * tstepA; const char* cB = (const char*)g.Bt + (size_t)cur.pn * tstepB;
    if constexpr (SP2) {
        PG8_STAGE(PG8_SB(0, 0), cB + PG8_KOFF(0), voffB); PG8_STAGE(PG8_SB(0, 1), cB + hstepB + PG8_KOFF(0), voffB); PG8_STAGE(PG8_SA(0, 0), cA + PG8_KOFF(0), voffA); PG8_STAGE(PG8_SA(0, 1), cA + hstepA + PG8_KOFF(0), voffA);
        if (wr == 1) PG8_BAR;
        PG8_WAIT_V(2); PG8_BAR;
        PG8_STAGE(PG8_SB(1, 0), cB + PG8_KOFF(1), voffB); PG8_STAGE(PG8_SA(1, 0), cA + PG8_KOFF(1), voffA); PG8_STAGE(PG8_SB(1, 1), cB + hstepB + PG8_KOFF(1), voffB);
        PG8_WAIT_V(6); PG8_BAR;
    } else {
        PG8_STAGE(PG8_SB(0, 0), cB, voffB); PG8_STAGE(PG8_SA(0, 0), cA, voffA); PG8_STAGE(PG8_SB(0, 1), cB + hstepB, voffB); PG8_STAGE(PG8_SA(0, 1), cA + hstepA, voffA);
        if (wr == 1) PG8_BAR;
        PG8_WAIT_V(4); PG8_BAR;
        PG8_STAGE(PG8_SB(1, 0), cB + kstep, voffB); PG8_STAGE(PG8_SA(1, 0), cA + kstep, voffA); PG8_STAGE(PG8_SB(1, 1), cB + hstepB + kstep, voffB);
        PG8_WAIT_V(6); PG8_BAR;
    }
    for (;;) {
        const bool has_next = S.next(ui + 1, nxt);
        const char* nA = has_next ? (const char*)g.A + (size_t)nxt.pm * tstepA : cA; const char* nB = has_next ? (const char*)g.Bt + (size_t)nxt.pn * tstepB : cB;
        for (int t = 0; t < nt; t += 2) {
            const bool last = (t == nt - 2);
            const char* a1 = cA + PG8_KOFF(t + 1);
            const char* a2 = last ? nA + PG8_KOFF(0) : cA + PG8_KOFF(t + 2); const char* b2 = last ? nB + PG8_KOFF(0) : cB + PG8_KOFF(t + 2);
            const char* a3 = last ? nA + PG8_KOFF(1) : cA + PG8_KOFF(t + 3); const char* b3 = last ? nB + PG8_KOFF(1) : cB + PG8_KOFF(t + 3);
            if constexpr (SP2) {
            int t_op = t; asm volatile("" : "+s"(t_op));
            const bool rlx = MK_RELAX_WAIT && (t_op == 0) && (ui > 0);
#define PG8_WAIT_V8X() do { if (rlx) asm volatile("s_waitcnt vmcnt(%0)" :: "n"(8 + Epi::NVM) : "memory"); else PG8_WAIT_V(8); } while (0)
            PG8_LDB(B0, 0, 0); PG8_LDB(B1, 0, 1); PG8_SCHED; PG8_LDA(At, 0, 0); PG8_STAGE(PG8_SA(1, 1), a1 + hstepA, voffA);
            PG8_WAIT_V8X(); PG8_WAIT_L(0); PG8_BAR; PG8_MMA(0, 0, At, B0); PG8_MMA(0, 1, At, B1); PG8_BAR; PG8_SCHED;
            PG8_LDA(At, 0, 1); PG8_STAGE(PG8_SB(0, 0), b2, voffB); PG8_STAGE(PG8_SB(0, 1), b2 + hstepB, voffB); PG8_STAGE(PG8_SA(0, 0), a2, voffA);
            PG8_WAIT_V8X(); PG8_WAIT_L(0); PG8_BAR; PG8_MMA(1, 0, At, B0); PG8_MMA(1, 1, At, B1); PG8_BAR; PG8_SCHED;
#undef PG8_WAIT_V8X
            PG8_LDB(B0, 1, 0); PG8_LDB(B1, 1, 1); PG8_SCHED; PG8_LDA(At, 1, 0); PG8_STAGE(PG8_SA(0, 1), a2 + hstepA, voffA);
            PG8_WAIT_V(8); PG8_WAIT_L(0); PG8_BAR; PG8_MMA(0, 0, At, B0); PG8_MMA(0, 1, At, B1); PG8_BAR; PG8_SCHED;
            PG8_LDA(At, 1, 1); PG8_STAGE(PG8_SB(1, 0), b3, voffB); PG8_STAGE(PG8_SB(1, 1), b3 + hstepB, voffB); PG8_STAGE(PG8_SA(1, 0), a3, voffA);
            PG8_WAIT_V(8); PG8_WAIT_L(0); PG8_BAR; PG8_MMA(1, 0, At, B0); PG8_MMA(1, 1, At, B1); PG8_BAR; PG8_SCHED;
            } else {
            PG8_LDB(B0, 0, 0); PG8_SCHED; PG8_LDA(At, 0, 0); PG8_STAGE(PG8_SA(1, 1), a1 + hstepA, voffA);
            PG8_WAIT_L(8); PG8_BAR; PG8_WAIT_L(0); PG8_MMA(0, 0, At, B0); PG8_BAR; PG8_SCHED;
            PG8_LDB(B1, 0, 1); PG8_STAGE(PG8_SB(0, 0), b2, voffB);
            PG8_BAR; PG8_WAIT_L(0); PG8_MMA(0, 1, At, B1); PG8_BAR;
            PG8_LDA(At, 0, 1); PG8_STAGE(PG8_SA(0, 0), a2, voffA);
            PG8_BAR; PG8_WAIT_L(0); PG8_MMA(1, 0, At, B0); PG8_BAR; PG8_SCHED;
            PG8_STAGE(PG8_SB(0, 1), b2 + hstepB, voffB);
            PG8_WAIT_V(6); PG8_BAR; PG8_MMA(1, 1, At, B1); PG8_BAR;
            PG8_LDB(B0, 1, 0); PG8_SCHED; PG8_LDA(At, 1, 0); PG8_STAGE(PG8_SA(0, 1), a2 + hstepA, voffA);
            PG8_WAIT_L(8); PG8_BAR; PG8_WAIT_L(0); PG8_MMA(0, 0, At, B0); PG8_BAR; PG8_SCHED;
            PG8_LDB(B1, 1, 1); PG8_STAGE(PG8_SB(1, 0), b3, voffB);
            PG8_BAR; PG8_WAIT_L(0); PG8_MMA(0, 1, At, B1); PG8_BAR;
            PG8_LDA(At, 1, 1); PG8_STAGE(PG8_SA(1, 0), a3, voffA);
            PG8_BAR; PG8_WAIT_L(0); PG8_MMA(1, 0, At, B0); PG8_BAR; PG8_SCHED;
            PG8_STAGE(PG8_SB(1, 1), b3 + hstepB, voffB);
            PG8_WAIT_V(6); PG8_BAR; PG8_MMA(1, 1, At, B1); PG8_BAR;
            }
        }
        if constexpr (ALIGN_EPI) { if (wr == 0) PG8_BAR; }
        if constexpr (I8) {
#pragma unroll
            for (int a = 0; a < 2; ++a)
#pragma unroll
                for (int b = 0; b < 2; ++b)
#pragma unroll
                    for (int m = 0; m < 4; ++m)
#pragma unroll
                        for (int n = 0; n < 2; ++n)
#pragma unroll
                            for (int q = 0; q < 4; ++q) acc[a][b][m][n][q] = (float)__float_as_int(acc[a][b][m][n][q]) * g.cs; }
        { int l2 = lane_id(); asm volatile("" : "+v"(l2));
          if constexpr (Epi::FUSED) { static_assert(ALIGN_EPI, "fused epilogues contain workgroup barriers: both halves must be aligned"); E.fused(acc, cur, wr, wc, l2 & 15, l2 >> 4, lds + STAGE_BYTES, wid); }
          else E(acc, cur, wr, wc, l2 & 15, l2 >> 4); }
        if (!has_next) break;
#pragma unroll
        for (int a = 0; a < 2; ++a)
#pragma unroll
            for (int b = 0; b < 2; ++b)
#pragma unroll
                for (int m = 0; m < 4; ++m)
#pragma unroll
                    for (int n = 0; n < 2; ++n) acc[a][b][m][n] = (f32x4){0.f, 0.f, 0.f, 0.f};
        cur = nxt; cA = nA; cB = nB; ++ui;
        if constexpr (ALIGN_EPI) { if (wr == 1) PG8_BAR; }
    }
    PG8_WAIT_V(0);
    if constexpr (!ALIGN_EPI) { if (wr == 0) PG8_BAR; }
    PG8_BAR;
#undef PG8_SA
#undef PG8_SB
#undef PG8_STAGE
#undef PG8_KOFF
#undef PG8_LDA
#undef PG8_LDB
#undef PG8_MMA
#undef PG8_WAIT_V
#undef PG8_WAIT_L
#undef PG8_BAR
#undef PG8_SCHED
}
}

#define XB_TMO      128
#define XB_XCNT(j)  (256  + 64 * (j))
#define XB_XSUB(j)  (1280 + 64 * (j))
#define XB_XGEN(j)  (2304 + 64 * (j))
#define XB_TOP      3328
#define XB_TOPGEN   3392
#define XCD_BAR_WORDS 3456
#define XB_SPIN_CAP (1u << 18)
__device__ __forceinline__ unsigned xb_ld(unsigned* p)              { return __hip_atomic_load(p, __ATOMIC_RELAXED, __HIP_MEMORY_SCOPE_AGENT); }
__device__ __forceinline__ unsigned xb_add(unsigned* p, unsigned v) { return __hip_atomic_fetch_add(p, v, __ATOMIC_RELAXED, __HIP_MEMORY_SCOPE_AGENT); }
__device__ __forceinline__ unsigned xb_xcc_id() { return (unsigned)__builtin_amdgcn_s_getreg((3 << 11) | 20) & 0xFu; }
#define XB_SPIN(cond, bar) do { unsigned _sp = 0; while (cond) { __builtin_amdgcn_s_sleep(1); \
    if ((++_sp & 255u) == 0u) { if (xb_ld(&(bar)[XB_TMO])) break; if (_sp > XB_SPIN_CAP) { atomicAdd(&(bar)[XB_TMO], 1u); break; } } } } while (0)
struct XcdBarrier { unsigned* bar; unsigned x; volatile LAS unsigned* st; };
__device__ __forceinline__ XcdBarrier xcd_barrier_post(unsigned* bar, volatile LAS unsigned* st, int wv) {
    XcdBarrier b; b.bar = bar; b.x = xb_xcc_id(); b.st = st;
    if (wv == 0 && lane_id() == 0) (void)xb_add(&bar[XB_XCNT(b.x)], 1u);
    return b;
}
__device__ __forceinline__ void xcd_barrier_complete(unsigned* bar, unsigned x, unsigned& nloc, unsigned& nx) {
    const unsigned G = gridDim.x * gridDim.y * gridDim.z;
    unsigned sum, cnt, mine, sp = 0u;
    for (;;) {
        sum = 0u; cnt = 0u; mine = 0u;
#pragma unroll
        for (unsigned j = 0; j < 16; ++j) { const unsigned c = xb_ld(&bar[XB_XCNT(j)]); sum += c; cnt += (c > 0u) ? 1u : 0u; mine = (j == x) ? c : mine; }
        if (sum == G) break;
        __builtin_amdgcn_s_sleep(1);
        if ((++sp & 255u) == 0u) { if (xb_ld(&bar[XB_TMO])) break; if (sp > XB_SPIN_CAP) { atomicAdd(&bar[XB_TMO], 1u); break; } }
    }
    nloc = mine > 0u ? mine : 1u; nx = cnt > 0u ? cnt : 1u;
}
__device__ __forceinline__ void xcd_barrier(const XcdBarrier& b, int wv) {
    asm volatile("s_waitcnt vmcnt(0)" ::: "memory");
    __syncthreads();
    if (wv == 0 && lane_id() == 0) {
        unsigned* bar = b.bar;
        __builtin_amdgcn_s_waitcnt(0);
        unsigned nloc = b.st[0], nx = b.st[1];
        if (nloc == 0u) { xcd_barrier_complete(bar, b.x, nloc, nx); b.st[0] = nloc; b.st[1] = nx; }
        const unsigned old = xb_add(&bar[XB_XSUB(b.x)], 1u);
        const unsigned gen = old / nloc;
        if (old + 1u == (gen + 1u) * nloc) {
            __builtin_amdgcn_fence(__ATOMIC_RELEASE, "agent");
            asm volatile("s_waitcnt vmcnt(0)" ::: "memory");
            const unsigned og = xb_add(&bar[XB_TOP], 1u);
            const unsigned tg = og / nx;
            if (og + 1u == (tg + 1u) * nx) xb_add(&bar[XB_TOPGEN], 1u);
            else XB_SPIN(xb_ld(&bar[XB_TOPGEN]) == tg, bar);
            __builtin_amdgcn_fence(__ATOMIC_ACQUIRE, "agent");
            xb_add(&bar[XB_XGEN(b.x)], 1u);
            asm volatile("s_waitcnt vmcnt(0)" ::: "memory");
        } else {
            XB_SPIN(xb_ld(&bar[XB_XGEN(b.x)]) == gen, bar);
            __builtin_amdgcn_fence(__ATOMIC_ACQUIRE, "agent");
            asm volatile("s_waitcnt vmcnt(0)" ::: "memory");
        }
    }
    __syncthreads();
}

__device__ __forceinline__ void ph_attn_simple(KP p, int vb, int G, int wv) {
    bf16* proj = (bf16*)(p->ws + WS_PROJ);
    const int tid_ = opaque_tid(wv); const int lane = tid_ & 63;
    for (int gw = vb * 8 + (tid_ >> 6); gw < 8192; gw += G * 8) {
        const int qb = gw & 31, h = (gw >> 5) & 15, b = gw >> 9, kvh = h >> 2;
        const size_t row = (size_t)b * SEQ + qb * 64 + lane;
        bf16* qp = proj + row * DIN + O_Q + h * 64;
        float q[64], acc[64];
#pragma unroll
        for (int c = 0; c < 8; ++c) { const u32x4 w = ((const u32x4*)qp)[c]; q[8 * c] = bflo(w.x); q[8 * c + 1] = bfhi(w.x); q[8 * c + 2] = bflo(w.y); q[8 * c + 3] = bfhi(w.y); q[8 * c + 4] = bflo(w.z); q[8 * c + 5] = bfhi(w.z); q[8 * c + 6] = bflo(w.w); q[8 * c + 7] = bfhi(w.w); }
#pragma unroll
        for (int d = 0; d < 64; ++d) acc[d] = 0.f;
        const bf16* kb = proj + (size_t)b * SEQ * DIN + O_K + kvh * 64; const bf16* vbp = proj + (size_t)b * SEQ * DIN + O_V + kvh * 64;
        float m = -1.0e30f, l = 0.f;
        for (int j = 0; j < SEQ; ++j) {
            const u32x4* kr = (const u32x4*)(kb + (size_t)j * DIN); float s = 0.f;
#pragma unroll
            for (int c = 0; c < 8; ++c) { const u32x4 w = kr[c]; s += q[8 * c] * bflo(w.x) + q[8 * c + 1] * bfhi(w.x) + q[8 * c + 2] * bflo(w.y) + q[8 * c + 3] * bfhi(w.y) + q[8 * c + 4] * bflo(w.z) + q[8 * c + 5] * bfhi(w.z) + q[8 * c + 6] * bflo(w.w) + q[8 * c + 7] * bfhi(w.w); }
            const float mn = fmaxf(m, s), a = exp2f(m - mn), pj = exp2f(s - mn); l = l * a + pj; m = mn;
            const u32x4* vr = (const u32x4*)(vbp + (size_t)j * DIN);
#pragma unroll
            for (int c = 0; c < 8; ++c) { const u32x4 w = vr[c];
                acc[8 * c] = acc[8 * c] * a + pj * bflo(w.x); acc[8 * c + 1] = acc[8 * c + 1] * a + pj * bfhi(w.x); acc[8 * c + 2] = acc[8 * c + 2] * a + pj * bflo(w.y); acc[8 * c + 3] = acc[8 * c + 3] * a + pj * bfhi(w.y);
                acc[8 * c + 4] = acc[8 * c + 4] * a + pj * bflo(w.z); acc[8 * c + 5] = acc[8 * c + 5] * a + pj * bfhi(w.z); acc[8 * c + 6] = acc[8 * c + 6] * a + pj * bflo(w.w); acc[8 * c + 7] = acc[8 * c + 7] * a + pj * bfhi(w.w); }
        }
        const float il = 1.0f / l;
#pragma unroll
        for (int c = 0; c < 8; ++c) { u32x4 w; w.x = pk2(acc[8 * c] * il, acc[8 * c + 1] * il); w.y = pk2(acc[8 * c + 2] * il, acc[8 * c + 3] * il); w.z = pk2(acc[8 * c + 4] * il, acc[8 * c + 5] * il); w.w = pk2(acc[8 * c + 6] * il, acc[8 * c + 7] * il); ((u32x4*)qp)[c] = w; }
    }
}
__device__ __forceinline__ void ph_conv_simple(KP p, int layer, LAS unsigned char* lds, int vb, int G, int wv) {
    LAS float* g = (LAS float*)lds; LAS float* pv = g + 4096;
    const int tid = opaque_tid(wv), half = tid >> 8, t0 = tid & 255;
    const bf16* Gf = (const bf16*)(p->ws + WS_GF) + (size_t)layer * 1024 * 2048; const bf16* Gb = (const bf16*)(p->ws + WS_GB) + (size_t)layer * 1024 * 2048;
    bf16* PT = (bf16*)(p->ws + WS_PT);
    for (int u = vb; u < 8192; u += G) {
        const int c = u >> 3, b = (u & 7) * 2 + half;
        __syncthreads();
        for (int i = tid; i < 4096; i += 512) g[i] = i <= 2047 ? bf2f(Gf[(size_t)c * 2048 + 2047 - i]) : (i < 4095 ? bf2f(Gb[(size_t)c * 2048 + i - 2047]) : 0.f);
        bf16* prow = PT + ((size_t)c * NB + b) * SEQ;
        for (int i = t0; i < 2048; i += 256) pv[half * 2048 + i] = bf2f(prow[i]);
        __syncthreads();
        float y[8];
#pragma unroll
        for (int k = 0; k < 8; ++k) y[k] = 0.f;
        for (int s = 0; s < 2048; ++s) { const float pp = pv[half * 2048 + s];
#pragma unroll
            for (int k = 0; k < 8; ++k) y[k] += g[s - (t0 + 256 * k) + 2047] * pp; }
#pragma unroll
        for (int k = 0; k < 8; ++k) prow[t0 + 256 * k] = (bf16)f2bf(y[k]);
    }
}


namespace attn_body {
using bf16=unsigned short;
using bf16x8=__attribute__((ext_vector_type(8)))short;
using s16x4=__attribute__((ext_vector_type(4)))short;
using f32x16=__attribute__((ext_vector_type(16)))float;
using u32x4=__attribute__((ext_vector_type(4)))unsigned;
constexpr int NHEAD=16,NKV=4,SEQ=2048,D=64,DM=8704;
constexpr int NW=8,QBLK=32,QB=QBLK*NW,KVBLK=64,NQB=SEQ/QB;
constexpr int ATTN_PITCH=DM, ATTN_UNIT_ROWS=QB;
__device__ __forceinline__ int crow(int r,int hi){return (r&3)+8*(r>>2)+4*hi;}
#define SBAR() __builtin_amdgcn_sched_barrier(0)
__device__ __forceinline__ void cmask(f32x16&p0,f32x16&p1,int jb,int qrel,int hi){
  const float NEG=-INFINITY; int kb=64*jb+4*hi;
  #pragma unroll
  for(int r=0;r<16;++r){int kv=kb+(r&3)+8*(r>>2); if(kv>qrel)p0[r]=NEG; if(kv+32>qrel)p1[r]=NEG;}
}

constexpr int NSLOT=3, SLOTB=8192;
constexpr int LDS_K=0, LDS_V=NSLOT*SLOTB, LDS_WS=2*NSLOT*SLOTB, LDS_OST=LDS_WS+NW*64*4, LDS_BYTES=LDS_OST+NW*4096;
constexpr float C2=0.125f*1.4426950408889634f;
__device__ __forceinline__ void glds16(const void*gsrc,unsigned lds_dst){unsigned keep;
  asm volatile("s_mov_b32 %0, m0\n\ts_mov_b32 m0, %2\n\ts_nop 0\n\tglobal_load_lds_dwordx4 %1, off\n\ts_mov_b32 m0, %0":"=&s"(keep):"v"(gsrc),"s"(lds_dst):"memory");}
__device__ __forceinline__ float max3f(float a,float b,float c){float r;asm("v_max3_f32 %0, %1, %2, %3":"=v"(r):"v"(a),"v"(b),"v"(c));return r;}
__device__ __forceinline__ float max2f(float a,float b){float r;asm("v_max_f32_e32 %0, %1, %2":"=v"(r):"v"(a),"v"(b));return r;}
__device__ __forceinline__ float fadd_s(float a,float b){float r;asm("v_add_f32_e32 %0, %1, %2":"=v"(r):"v"(a),"v"(b));return r;}
__device__ __forceinline__ float fsub_s(float a,float b){float r;asm("v_sub_f32_e32 %0, %1, %2":"=v"(r):"v"(a),"v"(b));return r;}
typedef float f32x2_t __attribute__((ext_vector_type(2))); typedef __bf16 bf16x2_t __attribute__((ext_vector_type(2)));
__device__ __forceinline__ unsigned cvtpk_s(float lo,float hi){f32x2_t v={lo,hi};bf16x2_t b=__builtin_convertvector(v,bf16x2_t);return __builtin_bit_cast(unsigned,b);}
#define WAIT_BAR(N) asm volatile("s_waitcnt vmcnt(" #N ") lgkmcnt(0)\n\ts_barrier":::"memory")

__device__ __forceinline__ void qkt(f32x16&p0,f32x16&p1,const char*Kslot,const bf16x8*qr,const f32x16&negm,int r32,int hi){
  const char*kb=Kslot+hi*1024+r32*16;
  #pragma unroll
  for(int d0=0;d0<4;++d0){
    const bf16x8 b0=*reinterpret_cast<const bf16x8*>(kb+d0*2048);
    const bf16x8 b1=*reinterpret_cast<const bf16x8*>(kb+d0*2048+512);
    if(d0==0){p0=__builtin_amdgcn_mfma_f32_32x32x16_bf16(b0,qr[0],negm,0,0,0);p1=__builtin_amdgcn_mfma_f32_32x32x16_bf16(b1,qr[0],negm,0,0,0);}
    else{p0=__builtin_amdgcn_mfma_f32_32x32x16_bf16(b0,qr[d0],p0,0,0,0);p1=__builtin_amdgcn_mfma_f32_32x32x16_bf16(b1,qr[d0],p1,0,0,0);}}
}
typedef __attribute__((address_space(3))) const char* lds_cptr;
typedef short v4i16_t __attribute__((ext_vector_type(4)));
__device__ __forceinline__ void kload8(bf16x8*kf,lds_cptr kp){
  kf[0]=*(const __attribute__((address_space(3))) bf16x8*)(kp);      kf[1]=*(const __attribute__((address_space(3))) bf16x8*)(kp+512);
  kf[2]=*(const __attribute__((address_space(3))) bf16x8*)(kp+2048); kf[3]=*(const __attribute__((address_space(3))) bf16x8*)(kp+2560);
  kf[4]=*(const __attribute__((address_space(3))) bf16x8*)(kp+4096); kf[5]=*(const __attribute__((address_space(3))) bf16x8*)(kp+4608);
  kf[6]=*(const __attribute__((address_space(3))) bf16x8*)(kp+6144); kf[7]=*(const __attribute__((address_space(3))) bf16x8*)(kp+6656);
}
__device__ __forceinline__ void kload2(bf16x8*kf,lds_cptr kp,int j){ kf[2*j]=*(const __attribute__((address_space(3))) bf16x8*)(kp+j*2048); kf[2*j+1]=*(const __attribute__((address_space(3))) bf16x8*)(kp+j*2048+512); }
__device__ __forceinline__ s16x4 vtr(lds_cptr p){ return __builtin_bit_cast(s16x4,__builtin_amdgcn_ds_read_tr16_b64_v4i16((__attribute__((address_space(3))) v4i16_t*)p)); }
__device__ __forceinline__ float rowmax(const f32x16&p0,const f32x16&p1){
  float a=max3f(p0[0],p0[1],p1[0]),b=max3f(p0[2],p0[3],p1[1]);a=max3f(a,p1[2],p1[3]);
  #pragma unroll
  for(int r=4;r<16;r+=4){a=max3f(a,p0[r],p0[r+1]);b=max3f(b,p0[r+2],p0[r+3]);a=max3f(a,p1[r],p1[r+1]);b=max3f(b,p1[r+2],p1[r+3]);}
  const float m=max2f(a,b);
  auto rr=__builtin_amdgcn_permlane32_swap(__float_as_uint(m),__float_as_uint(m),false,false);
  return max2f(__uint_as_float(rr[0]),__uint_as_float(rr[1]));
}
__device__ __forceinline__ void pv(f32x16*o,int vb,bf16x8 pa0,bf16x8 pa1,bf16x8 pa2,bf16x8 pa3){
  #pragma unroll
  for(int d0=0;d0<2;++d0){s16x4 lo[4],hi[4];
    #pragma unroll
    for(int ks=0;ks<4;++ks){
      asm volatile("ds_read_b64_tr_b16 %0,%1 offset:%c2":"=&v"(lo[ks]):"v"(vb),"i"(d0*4096+ks*1024):"memory");
      asm volatile("ds_read_b64_tr_b16 %0,%1 offset:%c2":"=&v"(hi[ks]):"v"(vb),"i"(d0*4096+ks*1024+512):"memory");}
    asm volatile("s_waitcnt lgkmcnt(0)":::"memory");SBAR();
    #define PK(k) (bf16x8){lo[k][0],lo[k][1],lo[k][2],lo[k][3],hi[k][0],hi[k][1],hi[k][2],hi[k][3]}
    o[d0]=__builtin_amdgcn_mfma_f32_32x32x16_bf16(pa0,PK(0),o[d0],0,0,0);
    o[d0]=__builtin_amdgcn_mfma_f32_32x32x16_bf16(pa1,PK(1),o[d0],0,0,0);
    o[d0]=__builtin_amdgcn_mfma_f32_32x32x16_bf16(pa2,PK(2),o[d0],0,0,0);
    o[d0]=__builtin_amdgcn_mfma_f32_32x32x16_bf16(pa3,PK(3),o[d0],0,0,0);
    #undef PK
  }
}

#ifndef ATTN_STORE16
#define ATTN_STORE16(p,v) (*(u32x4*)(p)=(v))
#endif
template<int THRL> __device__ __forceinline__ void attn_unit(int b,int h,int qb,const bf16*Q,const bf16*K,const bf16*V,bf16*O,char*shm,int wv){
  const int tid=opaque_tid(wv),lane=tid&63,r32=lane&31,hi=lane>>5; const int wid=__builtin_amdgcn_readfirstlane(tid>>6);
  const long rowbase=(long)b*SEQ; const int q0=qb*QB;
  const bf16*Qw=Q+(rowbase+q0+wid*QBLK)*DM;
  const bf16*Kh=K+rowbase*DM,*Vh=V+rowbase*DM; (void)h;
  const unsigned lds0=(unsigned)(uintptr_t)shm;
  float*wsf=(float*)(shm+LDS_WS)+wid*64;
  const bf16*ksrc=Kh+(long)lane*DM+wid*8;
  const bf16*vsrc=Vh+(long)(16*(wid&3)+(lane>>2))*DM+(wid>>2)*32+(lane&3)*8;
  const unsigned kdst=lds0+LDS_K+wid*1024, vdst=lds0+LDS_V+wid*1024;
  #define DMA_K(t,slot) glds16(ksrc+(long)(t)*KVBLK*DM,(unsigned)__builtin_amdgcn_readfirstlane(kdst+(slot)))
  #define DMA_V(t,slot) glds16(vsrc+(long)(t)*KVBLK*DM,(unsigned)__builtin_amdgcn_readfirstlane(vdst+(slot)))
  const int vb0=(int)(lds0+LDS_V)+((lane>>4)&1)*32+(lane&3)*8+(4*hi+((lane&15)>>2))*64;
  const char*Kbase=shm+LDS_K; bf16x8 kf[8];
  const lds_cptr shm3=(lds_cptr)shm; const lds_cptr kp0=shm3+LDS_K+hi*1024+r32*16; const lds_cptr vp0=shm3+LDS_V+((lane>>4)&1)*32+(lane&3)*8+(4*hi+((lane&15)>>2))*64;
  constexpr int NT=SEQ/KVBLK;
  DMA_K(0,0);DMA_V(0,0);DMA_K(1,SLOTB);
  bf16x8 qr[4];
  #pragma unroll
  for(int d0=0;d0<4;++d0)qr[d0]=*reinterpret_cast<const bf16x8*>(&Qw[(long)r32*DM+d0*16+hi*8]);
  float mhat=0.f,l_reg=0.f;f32x16 o[2];o[0]=f32x16{};o[1]=f32x16{};f32x16 negm=f32x16{};asm volatile("":"+v"(negm));
  #define CMASK(P0,P1,t) do{}while(0)
  bool resc=false;
  #define START(P0,P1) do{ const float rm=rowmax(P0,P1); resc=false; \
    { const float dl=rm; mhat=fadd_s(mhat,dl); \
      _Pragma("unroll") for(int r=0;r<16;++r){P0[r]=fsub_s(P0[r],dl);P1[r]=fsub_s(P1[r],dl);} \
      _Pragma("unroll") for(int r=0;r<16;++r)negm[r]=-mhat; asm volatile("":"+v"(negm)); } \
    _Pragma("unroll") for(int r=0;r<16;++r)P0[r]=__builtin_amdgcn_exp2f(P0[r]); }while(0)
  #define RESC() do{ if(resc){ asm volatile("s_waitcnt lgkmcnt(0)":::"memory"); \
      _Pragma("unroll") for(int d_=0;d_<2;++d_) _Pragma("unroll") for(int r=0;r<16;++r)o[d_][r]*=wsf[crow(r,hi)]; } }while(0)
  f32x16 pA0,pA1,pB0,pB1;
  int sl_prev=0,sl_cur=0,sl_next=SLOTB;
  #define ROT() do{sl_prev=sl_cur;sl_cur=sl_next;sl_next=(sl_next==(NSLOT-1)*SLOTB)?0:sl_next+SLOTB;}while(0)
  DMA_K(2,2*SLOTB);
  WAIT_BAR(3);
  qkt(pA0,pA1,Kbase,qr,negm,r32,hi);asm volatile("s_nop 15\n\ts_nop 7":"+v"(pA0),"+v"(pA1));CMASK(pA0,pA1,0);
  START(pA0,pA1);
  _Pragma("unroll") for(int r=0;r<16;++r)pA1[r]=__builtin_amdgcn_exp2f(pA1[r]);
  WAIT_BAR(0);
  DMA_K(3,0);DMA_V(1,SLOTB);
  ROT();
  kload8(kf,kp0+sl_cur);
  WAIT_BAR(2);
  s16x4 vlo[8],vhi[8]; u32x4 pw0,pw1,pw2,pw3;
  #define PKW(P,B) cvtpk_s(P[B],P[B+1])
  #define PAF(k) __builtin_bit_cast(bf16x8,pw##k)
  #define VFR(i) (bf16x8){vlo[i][0],vlo[i][1],vlo[i][2],vlo[i][3],vhi[i][0],vhi[i][1],vhi[i][2],vhi[i][3]}
  #define PIN(x) asm volatile("":"+v"(x))
  #define MX3(a,b,c) __builtin_fmaxf(__builtin_fmaxf((a),(b)),(c))
  #define GAPA(MF,A0,A1,A2,A3,W0,W1,PW) do{ MF; sacc+=A0; sacc+=A1; sacc+=A2; sacc+=A3; PIN(sacc); W0; W1; PIN(PW); SBAR(); }while(0)
  #define EX(v) __builtin_amdgcn_exp2f(v)
  #define GAPB(MF,X,B) do{ MF; X[B]=EX(X[B]); X[B+1]=EX(X[B+1]); X[B+2]=EX(X[B+2]); X[B+3]=EX(X[B+3]); PIN(X); SBAR(); }while(0)
  #define VRD(i) do{ vlo[i]=vtr(vp_+(((i)>>2)*4096+((i)&3)*1024)); vhi[i]=vtr(vp_+(((i)>>2)*4096+((i)&3)*1024+512)); }while(0)
  #define KRD(G,j) do{ if(G){ kload2(kf,kp0+sl_next,j); SBAR(); } }while(0)
  #define STEP(C0,C1,P0,P1,t,GK,GV,GL) do{ SBAR(); \
    const lds_cptr vp_=vp0+sl_prev; \
    VRD(0); SBAR(); float sacc=(P0[0]+P0[1]); \
    GAPA(C0=__builtin_amdgcn_mfma_f32_32x32x16_bf16(kf[0],qr[0],negm,0,0,0), P0[2],P0[3],P0[4],P0[5],     pw0[0]=PKW(P0,0), pw0[1]=PKW(P0,2), pw0); \
    VRD(4); SBAR(); GAPA(C1=__builtin_amdgcn_mfma_f32_32x32x16_bf16(kf[1],qr[0],negm,0,0,0), P0[6],P0[7],P0[8],P0[9],     pw0[2]=PKW(P0,4), pw0[3]=PKW(P0,6), pw0); \
    VRD(1); SBAR(); GAPA(C0=__builtin_amdgcn_mfma_f32_32x32x16_bf16(kf[2],qr[1],C0,0,0,0),   P0[10],P0[11],P0[12],P0[13], pw1[0]=PKW(P0,8), pw1[1]=PKW(P0,10), pw1); \
    VRD(5); SBAR(); GAPA(C1=__builtin_amdgcn_mfma_f32_32x32x16_bf16(kf[3],qr[1],C1,0,0,0),   P0[14],P0[15],P1[0],P1[1],   pw1[2]=PKW(P0,12),pw1[3]=PKW(P0,14), pw1); \
    VRD(2); SBAR(); GAPA(C0=__builtin_amdgcn_mfma_f32_32x32x16_bf16(kf[4],qr[2],C0,0,0,0),   P1[2],P1[3],P1[4],P1[5],     pw2[0]=PKW(P1,0), pw2[1]=PKW(P1,2), pw2); \
    VRD(6); SBAR(); GAPA(C1=__builtin_amdgcn_mfma_f32_32x32x16_bf16(kf[5],qr[2],C1,0,0,0),   P1[6],P1[7],P1[8],P1[9],     pw2[2]=PKW(P1,4), pw2[3]=PKW(P1,6), pw2); \
    VRD(3); SBAR(); GAPA(C0=__builtin_amdgcn_mfma_f32_32x32x16_bf16(kf[6],qr[3],C0,0,0,0),   P1[10],P1[11],P1[12],P1[13], pw3[0]=PKW(P1,8), pw3[1]=PKW(P1,10), pw3); \
    VRD(7); SBAR(); GAPA(C1=__builtin_amdgcn_mfma_f32_32x32x16_bf16(kf[7],qr[3],C1,0,0,0),   P1[14],P1[15],0.f,0.f,       pw3[2]=PKW(P1,12),pw3[3]=PKW(P1,14), pw3); \
    l_reg+=sacc; \
    if(GK){DMA_K((t)+3,sl_cur);} if(GV){DMA_V((t)+1,sl_next);} \
    CMASK(C0,C1,t); \
    { float a=MX3(C0[0],C0[1],C1[0]),b=MX3(C0[2],C0[3],C1[1]); a=MX3(a,C1[2],C1[3]); \
      _Pragma("unroll") for(int r=4;r<16;r+=4){a=MX3(a,C0[r],C0[r+1]);b=MX3(b,C0[r+2],C0[r+3]);a=MX3(a,C1[r],C1[r+1]);b=MX3(b,C1[r+2],C1[r+3]);} \
      float rm=__builtin_fmaxf(a,b); { auto rr=__builtin_amdgcn_permlane32_swap(__float_as_uint(rm),__float_as_uint(rm),false,false); rm=__builtin_fmaxf(__uint_as_float(rr[0]),__uint_as_float(rr[1])); } \
      resc=false; \
      if(__builtin_expect(__any(rm>(float)THRL),0)){ const float dl=__builtin_fmaxf(rm,0.f); mhat+=dl; \
        _Pragma("unroll") for(int r=0;r<16;++r){C0[r]-=dl;C1[r]-=dl;} \
        _Pragma("unroll") for(int r=0;r<16;++r)negm[r]=-mhat; asm volatile("":"+v"(negm)); \
        const float f=__builtin_amdgcn_exp2f(-dl); l_reg*=f; if(hi==0)wsf[r32]=f; resc=true; } } \
    SBAR(); \
    GAPB(o[0]=__builtin_amdgcn_mfma_f32_32x32x16_bf16(PAF(0),VFR(0),o[0],0,0,0), C0,0); \
    GAPB(o[1]=__builtin_amdgcn_mfma_f32_32x32x16_bf16(PAF(0),VFR(4),o[1],0,0,0), C0,4); \
    KRD(GL,0); GAPB(o[0]=__builtin_amdgcn_mfma_f32_32x32x16_bf16(PAF(1),VFR(1),o[0],0,0,0), C0,8); \
    KRD(GL,1); GAPB(o[1]=__builtin_amdgcn_mfma_f32_32x32x16_bf16(PAF(1),VFR(5),o[1],0,0,0), C0,12); \
    KRD(GL,2); GAPB(o[0]=__builtin_amdgcn_mfma_f32_32x32x16_bf16(PAF(2),VFR(2),o[0],0,0,0), C1,0); \
    KRD(GL,3); GAPB(o[1]=__builtin_amdgcn_mfma_f32_32x32x16_bf16(PAF(2),VFR(6),o[1],0,0,0), C1,4); \
    GAPB(o[0]=__builtin_amdgcn_mfma_f32_32x32x16_bf16(PAF(3),VFR(3),o[0],0,0,0), C1,8); \
    GAPB(o[1]=__builtin_amdgcn_mfma_f32_32x32x16_bf16(PAF(3),VFR(7),o[1],0,0,0), C1,12); \
    }while(0)
  int t=1;
  #undef CMASK
  #define CMASK(P0,P1,t) do{}while(0)
  for(;t+5<NT;t+=2){
    STEP(pB0,pB1,pA0,pA1,t,true,true,true);     WAIT_BAR(2); RESC(); ROT();
    STEP(pA0,pA1,pB0,pB1,t+1,true,true,true);   WAIT_BAR(2); RESC(); ROT();
  }
  #undef CMASK
  #define CMASK(P0,P1,t) do{}while(0)
  #define ENDW(tt) do{ if((tt)+3<NT){WAIT_BAR(2);} else if((tt)+2<NT){WAIT_BAR(1);} else {WAIT_BAR(0);} }while(0)
  for(;t+1<NT;t+=2){
    STEP(pB0,pB1,pA0,pA1,t,(t+3<NT),(t+1<NT),(t+1<NT));       ENDW(t);   RESC(); ROT();
    STEP(pA0,pA1,pB0,pB1,t+1,(t+4<NT),(t+2<NT),(t+2<NT));     ENDW(t+1); RESC(); ROT();
  }
  STEP(pB0,pB1,pA0,pA1,NT-1,false,false,false); RESC();
  { float sacc=pB0[0]+pB0[1]; _Pragma("unroll") for(int r=2;r<16;++r)sacc+=pB0[r]; _Pragma("unroll") for(int r=0;r<16;++r)sacc+=pB1[r]; l_reg+=sacc;
    pw0=(u32x4){PKW(pB0,0),PKW(pB0,2),PKW(pB0,4),PKW(pB0,6)};pw1=(u32x4){PKW(pB0,8),PKW(pB0,10),PKW(pB0,12),PKW(pB0,14)};pw2=(u32x4){PKW(pB1,0),PKW(pB1,2),PKW(pB1,4),PKW(pB1,6)};pw3=(u32x4){PKW(pB1,8),PKW(pB1,10),PKW(pB1,12),PKW(pB1,14)};
    SBAR(); pv(o,vb0+sl_cur,PAF(0),PAF(1),PAF(2),PAF(3)); }
  #undef PKW
  #undef PAF
  #undef VFR
  #undef PIN
  #undef MX3
  #undef GAPA
  #undef GAPB
  #undef EX
  #undef VRD
  #undef KRD
  #undef STEP
  #undef ENDW
  {auto rr=__builtin_amdgcn_permlane32_swap(__float_as_uint(l_reg),__float_as_uint(l_reg),false,false);l_reg=__uint_as_float(rr[0])+__uint_as_float(rr[1]);}
  if(hi==0)wsf[32+r32]=l_reg;asm volatile("s_waitcnt lgkmcnt(0)":::"memory");
  float rli[16];
  #pragma unroll
  for(int r=0;r<16;++r)rli[r]=__builtin_amdgcn_rcpf(wsf[32+crow(r,hi)]);
  bf16*Ow=O+(rowbase+q0+wid*QBLK)*DM;
  { bf16*stg=(bf16*)(shm+LDS_OST)+wid*2048;
    #pragma unroll
    for(int r=0;r<16;++r){const int orow=crow(r,hi);
      #pragma unroll
      for(int d0=0;d0<2;++d0)stg[orow*64+d0*32+r32]=(bf16)f2bf(o[d0][r]*rli[r]);}
    asm volatile("s_waitcnt lgkmcnt(0)":::"memory");
    #pragma unroll
    for(int i=0;i<4;++i){const int row=i*8+(lane>>3),ch=lane&7; const u32x4 v=*(const u32x4*)(stg+row*64+ch*8); ATTN_STORE16(Ow+(long)row*DM+ch*8,v);} }
  asm volatile("s_waitcnt lgkmcnt(0)\n\ts_barrier":::"memory");
  #undef DMA_K
  #undef DMA_V
  #undef CMASK
  #undef START
  #undef RESC
  #undef ROT
}
constexpr int ATTN_LDS_BYTES=LDS_BYTES;
#undef SBAR
#undef WAIT_BAR
}

__device__ __forceinline__ void ph_attn(KP p, char* lds_generic, int vcu, int G, int wv) {
    bf16* proj = (bf16*)(p->ws + WS_PROJ);
    for (int bh = vcu; bh < NB * 16; bh += G) { const int b = bh >> 4, h = bh & 15, kvh = h >> 2;
        for (int qb = 0; qb < SEQ / 256; ++qb)
            attn_body::attn_unit<8>(b, h, qb, proj + O_Q + h * 64, proj + O_K + kvh * 64, proj + O_V + kvh * 64, proj + O_Q + h * 64, lds_generic, wv); }
}

namespace hyconv {
constexpr int CB = 8256, PROW = 4112, OFF_P = 8 * CB, OFF_T = OFF_P + 16 * PROW, LDS_END = OFF_T + 8208;
static_assert(LDS_END <= 147200, "conv LDS");
__device__ __forceinline__ void ph_conv(KP p, int layer, LAS unsigned char* lds, int vb, int G, int wv) {
    const int tid = opaque_tid(wv), lane = tid & 63, wid = tid >> 6, fr = lane & 15, fq = lane >> 4;
    const bf16* Gf = (const bf16*)(p->ws + WS_GF) + (size_t)layer * 1024 * 2048; const bf16* Gb = (const bf16*)(p->ws + WS_GB) + (size_t)layer * 1024 * 2048;
    bf16* PT = (bf16*)(p->ws + WS_PT);
    const int tw = 256 * wid;
    const LAS unsigned char* tb = lds + (7 - (fr & 7)) * CB + (255 - (fr >> 3) + fq) * 16 - 2 * tw;
    const LAS unsigned char* pb = lds + OFF_P + fr * PROW + fq * 16;
    for (int c = vb; c < 1024; c += G) {
        __syncthreads();
        LAS bf16* tmp = (LAS bf16*)(lds + OFF_T);
        for (int i = tid; i < 4104; i += 512) { bf16 v = 0; if (i <= 2047) v = Gf[(size_t)c * 2048 + 2047 - i]; else if (i <= 4094) v = Gb[(size_t)c * 2048 + i - 2047]; tmp[i] = v; }
        { const u32x4* src = (const u32x4*)(PT + (size_t)c * NB * SEQ);
#pragma unroll
          for (int k = 0; k < 8; ++k) { const int q = tid + 512 * k; *(LAS u32x4*)(lds + OFF_P + (q >> 8) * PROW + (q & 255) * 16) = src[q]; } }
        __syncthreads();
        {
          const u32x4 lo = *(const LAS u32x4*)(lds + OFF_T + tid * 16), hi = *(const LAS u32x4*)(lds + OFF_T + tid * 16 + 16);
          const unsigned W[8] = {lo.x, lo.y, lo.z, lo.w, hi.x, hi.y, hi.z, hi.w};
#pragma unroll
          for (int k = 0; k < 8; ++k) { u32x4 o;
              if ((k & 1) == 0) { o.x = W[k / 2]; o.y = W[k / 2 + 1]; o.z = W[k / 2 + 2]; o.w = W[k / 2 + 3]; }
              else { const int b = (k - 1) / 2; o.x = (W[b] >> 16) | (W[b + 1] << 16); o.y = (W[b + 1] >> 16) | (W[b + 2] << 16); o.z = (W[b + 2] >> 16) | (W[b + 3] << 16); o.w = (W[b + 3] >> 16) | (W[b + 4] << 16); }
              *(LAS u32x4*)(lds + k * CB + tid * 16) = o; } }
        __syncthreads();
        f32x4 acc[16]; bf16x8 Wn[16];
#pragma unroll
        for (int i = 0; i < 16; ++i) { acc[i] = (f32x4){0.f, 0.f, 0.f, 0.f}; Wn[i] = *(const LAS bf16x8*)(tb - 32 * i); }
        bf16x8 pf = *(const LAS bf16x8*)pb;
        for (int j8 = 0; j8 < 8; ++j8) {
#pragma unroll
            for (int jj = 0; jj < 8; ++jj) {
                const int j = 8 * j8 + jj;
                const bf16x8 pcur = pf;
                if (j + 1 < 64) pf = *(const LAS bf16x8*)(pb + 64 * (j + 1));
#pragma unroll
                for (int i = 15; i >= 0; --i) {
                    acc[i] = __builtin_amdgcn_mfma_f32_16x16x32_bf16(Wn[(i - 2 * jj) & 15], pcur, acc[i], 0, 0, 0);
                    if (i == 14 && j + 1 < 64) {
                        Wn[(16 - 2 * (jj + 1)) & 15] = *(const LAS bf16x8*)(tb + 64 * (j + 1));
                        Wn[(17 - 2 * (jj + 1)) & 15] = *(const LAS bf16x8*)(tb + 64 * (j + 1) - 32); }
                }
            }
        }
        bf16* orow = PT + ((size_t)c * NB + fr) * SEQ + tw + 4 * fq;
#pragma unroll
        for (int i = 0; i < 16; ++i) { u32x2 w; w.x = pk2(acc[i][0], acc[i][1]); w.y = pk2(acc[i][2], acc[i][3]); *(u32x2*)(orow + 16 * i) = w; }
    }
}
}
#ifndef MK_ATTN_SIMPLE
#define MK_ATTN_SIMPLE 0
#endif
#ifndef MK_CONV_SIMPLE
#define MK_CONV_SIMPLE 0
#endif
constexpr int LDS_BYTES = 147456;
constexpr int MISC_OFF = 147200;
constexpr int CW_BAR = 4096;
constexpr int N_PHASES = 41;
#ifndef MK_GEMM_SP2
#define MK_GEMM_SP2 true
#endif
#ifndef MK_GEMM_ALIGN
#define MK_GEMM_ALIGN true
#endif

__global__ void __launch_bounds__(512, 2) k_mega(Params p_arg) {
    extern __shared__ __attribute__((aligned(16))) unsigned char lds_raw[];
    LAS unsigned char* lds = (LAS unsigned char*)lds_raw;
    (void)p_arg;
#define KARGS() ({ KP _k = (KP)__builtin_amdgcn_kernarg_segment_ptr(); asm volatile("" : "+s"(_k)); _k; })
    const int G = gridDim.x, vb = blockIdx.x;
    const int wv = __builtin_amdgcn_readfirstlane((int)threadIdx.x >> 6);
    volatile LAS unsigned* MISC = (volatile LAS unsigned*)(lds + MISC_OFF);
    if (wv == 0 && lane_id() < 32) MISC[lane_id()] = 0u;
    __syncthreads();
    int lo, hi; XcdBarrier bar;
    { KP p = KARGS(); lo = p->ph_lo; hi = p->ph_hi; bar = xcd_barrier_post((unsigned*)(p->ws + WS_CTL) + CW_BAR, MISC + 8, wv); }
#define IN(k) (lo <= (k) && (k) < hi)
#define SEAM(k) do { if (lo <= (k) && (k) + 1 < hi) xcd_barrier(bar, wv); } while (0)
#define WSP(T, off) ((T*)(ws + (off)))

#if MK_DENSE_I8 || MK_I8_GATES || MK_I8_MOE
    if (IN(0)) { { KP p = KARGS(); ph_wstats(p, vb, G, wv); } xcd_barrier(bar, wv); }
#endif
    if (IN(0)) { KP p = KARGS(); ph_transpose(p, lds, vb, G, wv); ph_ln_in(p, vb, G, wv); ph_rope(p, vb, G, wv); ph_filter(p, lds, vb, G, wv); }
    SEAM(0);
    for (int l = 0; l < 2; ++l) {
        const int base = 1 + 20 * l;
        if (IN(base + 0)) {
            if ((MK_I8_PROJ >> l) & 1) {
              { KP p = KARGS(); unsigned char* ws = p->ws;
                pg8::Gemm g{ws + WS_HF8, ws + WS_WIN8 + (size_t)l * DIN * DM, DM, DM, (i8_range_a(p, l ? 2 : 0) * (1.0f / 127.0f)) * (i8_range_w(p, 1) * (1.0f / 127.0f))};
                pg8::StaticOrder S{NT / 256, MK_I8_QKV_BF16 == 1 ? DIN / 256 - 6 : (MK_I8_QKV_BF16 == 2 ? DIN / 256 - 12 : DIN / 256), G, vb, 0, MK_I8_QKV_BF16 == 1 ? 12 : (MK_I8_QKV_BF16 == 2 ? 0 : (1 << 30)), MK_I8_QKV_BF16 == 1 ? 6 : (MK_I8_QKV_BF16 == 2 ? 12 : 0)};
                pg8::EpiProj E{WSP(bf16, WS_PROJ), DIN, p->in[13] + l * 64, p->in[14] + l * 64, WSP(float, WS_ROPE), WSP(float, WS_ROPE) + SEQ * 32};
                pg8::gemm_phase<pg8::EpiProj, pg8::StaticOrder, MK_GEMM_ALIGN, MK_GEMM_SP2, 1, true>(lds, g, S, E, wv); }
#if MK_I8_QKV_BF16
              asm volatile("s_waitcnt vmcnt(0)" ::: "memory"); __syncthreads();
              { KP p = KARGS(); unsigned char* ws = p->ws;
                constexpr int NB16 = MK_I8_QKV_BF16 == 1 ? O_G - O_Q : O_Q; pg8::Gemm g{WSP(bf16, WS_H0), WSP(bf16, WS_WIN) + (size_t)l * NB16 * DM, DM, DM}; pg8::StaticOrder S{NT / 256, NB16 / 256, G, vb, MK_I8_QKV_BF16 == 1 ? 12 : 0};
                pg8::EpiProj E{WSP(bf16, WS_PROJ), DIN, p->in[13] + l * 64, p->in[14] + l * 64, WSP(float, WS_ROPE), WSP(float, WS_ROPE) + SEQ * 32};
                pg8::gemm_phase<pg8::EpiProj, pg8::StaticOrder, MK_GEMM_ALIGN, MK_GEMM_SP2>(lds, g, S, E, wv); }
#endif
            } else {
            KP p = KARGS(); unsigned char* ws = p->ws;
            { pg8::Gemm g{WSP(bf16, WS_H0), WSP(bf16, WS_WIN) + (size_t)l * NPB * DM, DM, DM}; pg8::StaticOrder S{NT / 256, NPB / 256, G, vb};
#if MK_QK_EPI
              pg8::EpiProj E{WSP(bf16, WS_PROJ), DIN, p->in[13] + l * 64, p->in[14] + l * 64, WSP(float, WS_ROPE), WSP(float, WS_ROPE) + SEQ * 32};
              pg8::gemm_phase<pg8::EpiProj, pg8::StaticOrder, MK_GEMM_ALIGN, MK_GEMM_SP2>(lds, g, S, E, wv); }
#else
              pg8::EpiStore E{WSP(bf16, WS_PROJ), DIN};
              pg8::gemm_phase<pg8::EpiStore, pg8::StaticOrder, MK_GEMM_ALIGN, MK_GEMM_SP2>(lds, g, S, E, wv); }
#endif
            asm volatile("s_waitcnt vmcnt(0)" ::: "memory"); __syncthreads();
            {
              KP p2 = KARGS(); unsigned char* ws2 = p2->ws;
              pg8::Gemm g{ws2 + WS_HF8, ws2 + WS_WING + (size_t)l * 4096 * DM, DM, DM}; pg8::StaticOrder S{NT / 256, 4096 / 256, G, vb}; pg8::EpiStoreScaled E{(bf16*)(ws2 + WS_PROJ) + O_G, DIN, MK_I8_GATES ? (i8_range_a(p2, l ? 2 : 0) * (1.0f / 127.0f)) * (i8_range_w(p2, 1) * (1.0f / 127.0f)) : 1.0f / SC_GU};
              pg8::gemm_phase<pg8::EpiStoreScaled, pg8::StaticOrder, MK_GEMM_ALIGN, MK_GEMM_SP2, 1, MK_I8_GATES != 0>(lds, g, S, E, wv); }
            }
        }
        SEAM(base + 0);
        if (IN(base + 1)) { KP p = KARGS(); if (!MK_QK_EPI) ph_qk_prep(p, l, vb, G, wv); ph_hy_prep(p, l, lds, vb, G, wv); }
        SEAM(base + 1);
        if (IN(base + 2)) { KP p = KARGS(); const int vcu = (G % 8 == 0) ? (vb % 8) * (G / 8) + vb / 8 : vb;
#if MK_ATTN_SIMPLE
            ph_attn_simple(p, vb, G, wv);
#else
            ph_attn(p, (char*)lds_raw, vcu, G, wv); __syncthreads();
#endif
#if MK_CONV_SIMPLE
            ph_conv_simple(p, l, lds, vb, G, wv);
#else
            hyconv::ph_conv(p, l, lds, vb, G, wv);
#endif
        }
        SEAM(base + 2);
        if (IN(base + 3)) { KP p = KARGS(); ph_hy_post(p, l, lds, vb, G, wv); }
        SEAM(base + 3);
        if (IN(base + 4)) {
#if MK_WO_I8
            static_assert(MK_I8_PROJ == 3 && MK_I8_QKV_BF16 == 0, "the int8 merged buffer lives in the WIN / WING slots");
            { KP p = KARGS(); unsigned char* ws = p->ws; bf16* PROJ = WSP(bf16, WS_PROJ);
              pg8::Gemm g{WSP(bf16, WS_YHY), WSP(bf16, WS_WHB) + (size_t)l * DM * DH, DH, DH}; pg8::PanelOrder S{NT / 256, G, vb}; pg8::EpiGate<false> E{PROJ + O_G, DIN, PROJ, DIN};
              pg8::gemm_phase<pg8::EpiGate<false>, pg8::PanelOrder, true, MK_GEMM_SP2>(lds, g, S, E, wv); }
            asm volatile("s_waitcnt vmcnt(0)" ::: "memory"); __syncthreads();
            { KP p = KARGS(); unsigned char* ws = p->ws; bf16* PROJ = WSP(bf16, WS_PROJ);
              pg8::Gemm g{PROJ + O_Q, WSP(bf16, WS_WAB) + (size_t)l * DM * DA, DIN, DA}; pg8::PanelOrder S{NT / 256, G, vb};
              pg8::EpiGateQ E{PROJ + O_G + DM, DIN, PROJ, DIN, ws + WS_M8, WSP(float, WS_XBUF + 12 * MiB), WSP(unsigned, WS_XBUF + 8 * MiB) + (size_t)l * NT * 8, WSP(unsigned, WS_CTL) + CW_PANEL + (4 + l) * 8192, WSP(unsigned, WS_CTL) + CW_TMO};
              pg8::gemm_phase<pg8::EpiGateQ, pg8::PanelOrder, true, MK_GEMM_SP2>(lds, g, S, E, wv); }
#else
            { KP p = KARGS(); unsigned char* ws = p->ws; bf16* PROJ = WSP(bf16, WS_PROJ);
              pg8::Gemm g{WSP(bf16, WS_YHY), WSP(bf16, WS_WHB) + (size_t)l * DM * DH, DH, DH}; pg8::StaticOrder S{NT / 256, DM / 256, G, vb}; pg8::EpiGate<false> E{PROJ + O_G, DIN, PROJ, DIN};
              pg8::gemm_phase<pg8::EpiGate<false>, pg8::StaticOrder, MK_GEMM_ALIGN, MK_GEMM_SP2>(lds, g, S, E, wv); }
            asm volatile("s_waitcnt vmcnt(0)" ::: "memory"); __syncthreads();
            { KP p = KARGS(); unsigned char* ws = p->ws; bf16* PROJ = WSP(bf16, WS_PROJ);
              pg8::Gemm g{PROJ + O_Q, WSP(bf16, WS_WAB) + (size_t)l * DM * DA, DIN, DA}; pg8::StaticOrder S{NT / 256, DM / 256, G, vb}; pg8::EpiGate<true> E{PROJ + O_G + DM, DIN, PROJ, DIN, MK_WO_F8 ? ws + WS_WIN : nullptr};
              pg8::gemm_phase<pg8::EpiGate<true>, pg8::StaticOrder, MK_GEMM_ALIGN, MK_GEMM_SP2>(lds, g, S, E, wv); }
#endif
        }
        SEAM(base + 4);
        if (IN(base + 5)) {
            KP p = KARGS(); unsigned char* ws = p->ws;
#if MK_WO_I8
            pg8::Gemm g{ws + WS_M8, ws + WS_WO + (size_t)l * DM * DM, DM, DM};
#elif MK_WO_F8
            pg8::Gemm g{ws + WS_WIN, ws + WS_WO + (size_t)l * DM * DM, DM, DM};
#else
            pg8::Gemm g{WSP(bf16, WS_PROJ), WSP(bf16, WS_WO) + (size_t)l * DM * DM, DIN, DM};
#endif
            pg8::StaticOrder S{NT / 256, DM / 256, G, vb}; float al_ = ALPHA; asm volatile("" : "+s"(al_));
#if MK_LN_FUSE
            {
                pg8::EpiResLn E{WSP(bf16, WS_H0), WSP(bf16, WS_H1), (l || MK_DENSE_I8) ? ws + WS_HF8 : nullptr, p->in[18] + l * DM, p->in[19] + l * DM, MK_WO_I8 ? i8_range_w(p, 3) * (1.0f / 127.0f) : (MK_WO_F8 ? 1.0f / 64.0f : 1.0f), al_, WSP(unsigned long long, WS_XBUF) + (size_t)l * 2 * NT * 8, WSP(unsigned, WS_CTL) + CW_PANEL + l * 2 * 8192, WSP(unsigned, WS_CTL) + CW_TMO, (l == 0 ? MK_DENSE_I8 : MK_I8_MOE) ? 127.0f / i8_range_a(p, l ? 3 : 1) : 0.f, MK_WO_I8 ? WSP(float, WS_XBUF + 12 * MiB) : nullptr};
                pg8::PanelOrder SP{NT / 256, G, vb};
                pg8::gemm_phase<pg8::EpiResLn, pg8::PanelOrder, true, MK_GEMM_SP2, (MK_WO_F8 || MK_WO_I8) ? 1 : 2, MK_WO_I8 != 0>(lds, g, SP, E, wv);
            }
#else
            { pg8::EpiRes E{WSP(bf16, WS_H0), p->out, 1.0f, al_};
              pg8::gemm_phase<pg8::EpiRes, pg8::StaticOrder, MK_GEMM_ALIGN, MK_GEMM_SP2>(lds, g, S, E, wv); }
#endif
        }
        SEAM(base + 5);
        if (l == 0) {
#if !MK_LN_FUSE
            if (IN(base + 6)) { KP p = KARGS(); ph_ln<false>(p, p->in[18], p->in[19], (bf16*)(p->ws + WS_H1), lds, vb, G, wv); }
            SEAM(base + 6);
#endif
            if (IN(base + 7)) {
                KP p = KARGS(); unsigned char* ws = p->ws;
#if MK_DENSE_I8
                const float s8 = (i8_range_a(p, 1) * (1.0f / 127.0f)) * (i8_range_w(p, 0) * (1.0f / 127.0f));
                pg8::Gemm g{ws + WS_HF8, ws + WS_WGU, DM, DM}; pg8::StaticOrder S{NT / 256, 2 * FF / 256, G, vb}; pg8::EpiSwigluF8 E{ws + WS_G, FF, s8};
                pg8::gemm_phase<pg8::EpiSwigluF8, pg8::StaticOrder, MK_GEMM_ALIGN, MK_GEMM_SP2, 1, true>(lds, g, S, E, wv);
#elif MK_DENSE_F8
                pg8::Gemm g{ws + WS_HF8, ws + WS_WGU, DM, DM}; pg8::StaticOrder S{NT / 256, 2 * FF / 256, G, vb}; pg8::EpiSwigluF8 E{ws + WS_G, FF, 1.0f / SC_GU};
                pg8::gemm_phase<pg8::EpiSwigluF8, pg8::StaticOrder, MK_GEMM_ALIGN, MK_GEMM_SP2, 1>(lds, g, S, E, wv);
#elif MK_DENSE_DN_F8
                pg8::Gemm g{WSP(bf16, WS_H1), WSP(bf16, WS_WGU), DM, DM}; pg8::StaticOrder S{NT / 256, 2 * FF / 256, G, vb}; pg8::EpiSwigluF8 E{ws + WS_G, FF, 1.0f};
                pg8::gemm_phase<pg8::EpiSwigluF8, pg8::StaticOrder, MK_GEMM_ALIGN, MK_GEMM_SP2>(lds, g, S, E, wv);
#else
                pg8::Gemm g{WSP(bf16, WS_H1), WSP(bf16, WS_WGU), DM, DM}; pg8::StaticOrder S{NT / 256, 2 * FF / 256, G, vb}; pg8::EpiSwiglu E{WSP(bf16, WS_G), FF};
                pg8::gemm_phase<pg8::EpiSwiglu, pg8::StaticOrder, MK_GEMM_ALIGN, MK_GEMM_SP2>(lds, g, S, E, wv);
#endif
            }
            SEAM(base + 7);
            if (IN(base + 8)) {
                KP p = KARGS(); unsigned char* ws = p->ws;
                pg8::Gemm g{ws + WS_G, ws + WS_WD, FF, FF}; pg8::StaticOrder S{NT / 256, DM / 256, G, vb}; float al_ = ALPHA; asm volatile("" : "+s"(al_));
#if MK_LN_FUSE
                pg8::EpiResLn E{WSP(bf16, WS_H1), WSP(bf16, WS_H0), ws + WS_HF8, p->in[28], p->in[29], (MK_DENSE_F8 || MK_DENSE_DN_F8) ? 1.0f / SC_DN : 1.0f, al_, WSP(unsigned long long, WS_XBUF) + (size_t)NT * 8, WSP(unsigned, WS_CTL) + CW_PANEL + 8192, WSP(unsigned, WS_CTL) + CW_TMO, MK_I8_GATES ? 127.0f / i8_range_a(p, 2) : 0.f};
                pg8::PanelOrder SP{NT / 256, G, vb};
                pg8::gemm_phase<pg8::EpiResLn, pg8::PanelOrder, true, MK_GEMM_SP2, (MK_DENSE_F8 || MK_DENSE_DN_F8) ? 1 : 2>(lds, g, SP, E, wv);
#else
                pg8::EpiRes E{WSP(bf16, WS_H1), p->out, (MK_DENSE_F8 || MK_DENSE_DN_F8) ? 1.0f / SC_DN : 1.0f, al_};
                pg8::gemm_phase<pg8::EpiRes, pg8::StaticOrder, MK_GEMM_ALIGN, MK_GEMM_SP2, (MK_DENSE_F8 || MK_DENSE_DN_F8) ? 1 : 2>(lds, g, S, E, wv);
#endif
            }
#if MK_LN_FUSE
            if (lo <= base + 8 && base + 20 < hi) xcd_barrier(bar, wv);
#else
            SEAM(base + 8);
            if (IN(base + 9)) { KP p = KARGS(); ph_ln<false>(p, p->in[28], p->in[29], (bf16*)(p->ws + WS_H0), lds, vb, G, wv); }
            if (lo <= base + 9 && base + 20 < hi) xcd_barrier(bar, wv);
#endif
        } else {
#if MK_LN_FUSE
            if (IN(base + 6)) { KP p = KARGS(); ph_router(p, lds, vb, G, wv); }
#else
            if (IN(base + 6)) { KP p = KARGS(); ph_ln<true>(p, p->in[18] + DM, p->in[19] + DM, (bf16*)(p->ws + WS_H1), lds, vb, G, wv); }
#endif
            SEAM(base + 6);
            if (IN(base + 7)) { KP p = KARGS(); ph_gather(p, vb, G, wv); }
            SEAM(base + 7);
            for (int c = 0; c < 1; ++c) {
                int ntl, tile0;
                { KP p = KARGS(); const int ntiles = (int)__hip_atomic_load((unsigned*)(p->ws + WS_CTL) + CW_NTILES, __ATOMIC_RELAXED, __HIP_MEMORY_SCOPE_AGENT);
                  tile0 = c * CHUNK_TILES; ntl = ntiles - tile0; ntl = ntl < 0 ? 0 : (ntl > CHUNK_TILES ? CHUNK_TILES : ntl); }
                if (IN(base + 8 + 2 * c) && ntl > 0) {
                    KP p = KARGS(); unsigned char* ws = p->ws;
                    pg8::Gemm g{ws + WS_XG, ws + WS_EGU, DM, DM}; pg8::GroupedOrder S{ntl, tile0, 2 * FE / 256, G, vb, WSP(unsigned, WS_CTL) + CW_TILE_E, false}; pg8::EpiSwigluF8 E{ws + WS_HM, FE, MK_I8_MOE ? (i8_range_a(p, 3) * (1.0f / 127.0f)) * (i8_range_w(p, 2) * (1.0f / 127.0f)) : 1.0f / SC_GU};
                    pg8::gemm_phase<pg8::EpiSwigluF8, pg8::GroupedOrder, MK_GEMM_ALIGN, MK_GEMM_SP2, 1, MK_I8_MOE != 0>(lds, g, S, E, wv);
                }
                SEAM(base + 8 + 2 * c);
                if (IN(base + 9 + 2 * c) && ntl > 0) {
                    KP p = KARGS(); unsigned char* ws = p->ws;
                    pg8::Gemm g{ws + WS_HM, ws + WS_ED, FE, FE}; pg8::GroupedOrder S{ntl, tile0, DM / 256, G, vb, WSP(unsigned, WS_CTL) + CW_TILE_E, true}; pg8::EpiStoreScaled E{WSP(bf16, WS_YG), DM, 1.0f / SC_DN};
                    pg8::gemm_phase<pg8::EpiStoreScaled, pg8::GroupedOrder, MK_GEMM_ALIGN, MK_GEMM_SP2, 1>(lds, g, S, E, wv);
                }
                SEAM(base + 9 + 2 * c);
            }
            if (IN(base + 18)) { KP p = KARGS(); ph_combine_ln(p, p->in[28] + DM, p->in[29] + DM, vb, G, wv); }
        }
    }
#undef IN
#undef SEAM
}

#ifndef MK_SPLIT
#define MK_SPLIT 0
#endif
extern "C" void kernel_launch(void* const* d_in, const int* in_sizes, int n_in, void* d_out, int out_size, void* d_ws, size_t ws_size, hipStream_t stream) {
    static int ready = 0;
    if (ready == 0) {
        if (n_in != 30 || out_size != NT * DM || ws_size < WS_END) { fprintf(stderr, "kernel_launch: unexpected shapes (n_in %d out %d ws %zu need %zu)\n", n_in, out_size, ws_size, (size_t)WS_END); ready = -1; return; }
        if (hipFuncSetAttribute((const void*)k_mega, hipFuncAttributeMaxDynamicSharedMemorySize, LDS_BYTES) != hipSuccess) { fprintf(stderr, "kernel_launch: hipFuncSetAttribute failed\n"); ready = -1; return; }
        ready = 1;
    }
    if (ready < 0) return;
    unsigned char* ws = (unsigned char*)d_ws;
    (void)hipMemsetAsync(ws + WS_CTL, 0, 1 * MiB, stream);
    Params p; memset(&p, 0, sizeof(p));
    for (int i = 0; i < 30; ++i) p.in[i] = (const float*)d_in[i];
    p.out = (float*)d_out; p.ws = ws;
#if MK_SPLIT
    for (int ph = 0; ph < N_PHASES; ++ph) {
        const int k = ph == 0 ? -1 : (ph - 1) % 20, l = ph == 0 ? 0 : (ph - 1) / 20;
        if (l == 0 && k >= 10) continue;
        if (l == 1 && k == 19) continue;
        p.ph_lo = ph; p.ph_hi = ph + 1;
        hipLaunchKernelGGL(k_mega, dim3(256), dim3(512), LDS_BYTES, stream, p);
    }
#else
    p.ph_lo = 0; p.ph_hi = N_PHASES;
    hipLaunchKernelGGL(k_mega, dim3(256), dim3(512), LDS_BYTES, stream, p);
#endif
}
```

```cpp
#include <hip/hip_runtime.h>
#include <cstdio>
#include <cstdint>
#include <cstring>

#define LAS __attribute__((address_space(3)))
typedef unsigned short bf16;
typedef short bf16x8 __attribute__((ext_vector_type(8)));
typedef float f32x4 __attribute__((ext_vector_type(4)));
typedef float f32x2 __attribute__((ext_vector_type(2)));
typedef unsigned u32x4 __attribute__((ext_vector_type(4)));
typedef unsigned u32x2 __attribute__((ext_vector_type(2)));

constexpr int NB = 16, SEQ = 2048, DM = 2048, NT = NB * SEQ;
constexpr int DH = 1024, DA = 1024, DKV = 256, DIN = 3 * DH + DA + 2 * DKV + 2 * DM;
constexpr int O_Q = 3 * DH, O_K = O_Q + DA, O_V = O_K + DKV, O_G = O_V + DKV;
constexpr int FF = 5632, FE = 7168, NE = 8;
constexpr float LN_EPS = 1e-5f, RMS_EPS = 1e-6f;
constexpr float ALPHA = 1.41421356237309515f;
constexpr float QSCALE = 0.125f * 1.4426950408889634f;
constexpr int MAXTILES = 264;
constexpr int CHUNK_TILES = 264;
#ifndef MK_QK_EPI
#define MK_QK_EPI 1
#endif
#ifndef MK_DENSE_DN_F8
#define MK_DENSE_DN_F8 1
#endif
#ifndef MK_I8_GATES
#define MK_I8_GATES 1
#endif
#ifndef MK_I8_PROJ
#define MK_I8_PROJ 3
#endif
#ifndef MK_I8_QKV_BF16
#define MK_I8_QKV_BF16 0
#endif
#ifndef MK_BR1_I8
#define MK_BR1_I8 0
#endif
#ifndef MK_WO_I8
#define MK_WO_I8 1
#endif
#ifndef MK_WO_F8
#define MK_WO_F8 0
#endif
#ifndef MK_I8_MOE
#define MK_I8_MOE 1
#endif
#ifndef MK_DENSE_I8
#define MK_DENSE_I8 1
#endif
#ifndef MK_DENSE_F8
#define MK_DENSE_F8 0
#endif
constexpr float SC_GU = 32.f, SC_DN = 128.f;

constexpr size_t MiB = 1u << 20;
constexpr size_t WS_CTL = 0;
constexpr size_t WS_ROPE = 1 * MiB;
constexpr size_t WS_TOK = 2 * MiB;
constexpr size_t WS_GF = 3 * MiB;
constexpr size_t WS_GB = 11 * MiB;
constexpr size_t WS_WIN = 19 * MiB;
constexpr size_t WS_WING = WS_WIN + 36 * MiB;
constexpr int NPB = O_G;
constexpr size_t WS_WHB = 87 * MiB;
constexpr size_t WS_WAB = 95 * MiB;
constexpr size_t WS_WO = 103 * MiB;
constexpr size_t WS_WGU = 119 * MiB;
constexpr size_t WS_WD = 163 * MiB;
constexpr size_t WS_EGU = 185 * MiB;
constexpr size_t WS_HF8 = 409 * MiB;
constexpr size_t WS_M8 = 19 * MiB;
constexpr size_t WS_XBUF = 480 * MiB;
constexpr size_t WS_ED = 633 * MiB;
constexpr size_t WS_H0 = 857 * MiB;
constexpr size_t WS_H1 = 985 * MiB;
constexpr size_t WS_PROJ = 1113 * MiB;
constexpr size_t WS_YHY = 1657 * MiB;
constexpr size_t WS_PT = 1721 * MiB;
constexpr size_t WS_END_MIX = 1785 * MiB;
constexpr size_t WS_G = WS_PROJ;
constexpr size_t WS_XG = WS_PROJ;
constexpr size_t WS_YG = WS_PROJ;
constexpr size_t WS_HM = WS_PROJ + 264 * MiB;
constexpr size_t WS_WIN8 = WS_HM + 462 * MiB;
constexpr size_t WS_END = WS_WIN8 + 34 * MiB;
constexpr int CW_CNT = 64;
constexpr int CW_NTILES = 128;
constexpr int CW_TILE_E = 192;
constexpr int CW_TBASE = 512;
constexpr int CW_AMAX = 1024;
constexpr int CW_SSQ = 1040;
constexpr float I8_ACLIP = 4.25f;
constexpr float I8_WCLIP = 4.25f;
constexpr int CW_TMO = 0;
constexpr int CW_PANEL = 8192;

struct Params {
    const float* in[30];
    float* out;
    unsigned char* ws;
    int ph_lo, ph_hi;
};

typedef const __attribute__((address_space(4))) Params* KP;
__device__ __forceinline__ unsigned f2bf(float f) { unsigned u = __float_as_uint(f); return (u + 0x7fffu + ((u >> 16) & 1u)) >> 16; }
__device__ __forceinline__ unsigned pk2(float lo, float hi) { return f2bf(lo) | (f2bf(hi) << 16); }
__device__ __forceinline__ float bflo(unsigned w) { return __uint_as_float(w << 16); }
__device__ __forceinline__ float bfhi(unsigned w) { return __uint_as_float(w & 0xffff0000u); }
__device__ __forceinline__ float bf2f(bf16 b) { return __uint_as_float(((unsigned)b) << 16); }
__device__ __forceinline__ unsigned pk4_fp8(float a, float b, float c, float d) { int w = __builtin_amdgcn_cvt_pk_fp8_f32(a, b, 0, false); w = __builtin_amdgcn_cvt_pk_fp8_f32(c, d, w, true); return (unsigned)w; }
__device__ __forceinline__ unsigned pk4_i8(float a, float b, float c, float d, float qs) {
    const float M = 12582912.0f;
    const unsigned ua = __float_as_uint(__builtin_amdgcn_fmed3f(a * qs, -127.f, 127.f) + M), ub = __float_as_uint(__builtin_amdgcn_fmed3f(b * qs, -127.f, 127.f) + M);
    const unsigned uc = __float_as_uint(__builtin_amdgcn_fmed3f(c * qs, -127.f, 127.f) + M), ud = __float_as_uint(__builtin_amdgcn_fmed3f(d * qs, -127.f, 127.f) + M);
    return __builtin_amdgcn_perm(ub, ua, 0x0c0c0400u) | __builtin_amdgcn_perm(ud, uc, 0x04000c0cu);
}
template <int M> __device__ __forceinline__ float swz_xor(float v) { return __int_as_float(__builtin_amdgcn_ds_swizzle(__float_as_int(v), 0x1f | (M << 10))); }
__device__ __forceinline__ float wave_sum(float v) {
    v += swz_xor<1>(v); v += swz_xor<2>(v); v += swz_xor<4>(v); v += swz_xor<8>(v); v += swz_xor<16>(v);
    const auto rr = __builtin_amdgcn_permlane32_swap(__float_as_uint(v), __float_as_uint(v), false, false);
    return __uint_as_float(rr[0]) + __uint_as_float(rr[1]);
}
__device__ __forceinline__ int lane_id() { int l; asm volatile("v_mbcnt_lo_u32_b32 %0, -1, 0\n\tv_mbcnt_hi_u32_b32 %0, -1, %0" : "=v"(l)); return l; }
__device__ __forceinline__ int opaque_tid(int wv) { int t = (wv << 6) | lane_id(); asm volatile("" : "+v"(t)); return t; }
__device__ __forceinline__ float sigmoidf_(float x) { return 1.0f / (1.0f + __expf(-x)); }

__device__ __forceinline__ void transpose_item(const float* W, int K, int N, bf16* WT, int orow0, int k0, int n0, LAS float* scr, int lane) {
#pragma unroll 8
    for (int i = 0; i < 32; ++i) { const int kk = 2 * i + (lane >> 5); scr[kk * 33 + (lane & 31)] = W[(size_t)(k0 + kk) * N + n0 + (lane & 31)]; }
    asm volatile("s_waitcnt lgkmcnt(0)" ::: "memory");
    const int c = lane & 7;
#pragma unroll
    for (int j = 0; j < 4; ++j) { const int n = (lane >> 3) + 8 * j; const LAS float* s = scr + (8 * c) * 33 + n;
        u32x4 o; o.x = pk2(s[0 * 33], s[1 * 33]); o.y = pk2(s[2 * 33], s[3 * 33]); o.z = pk2(s[4 * 33], s[5 * 33]); o.w = pk2(s[6 * 33], s[7 * 33]);
        *(u32x4*)(WT + (size_t)(orow0 + n) * K + k0 + 8 * c) = o; }
    asm volatile("s_waitcnt lgkmcnt(0)" ::: "memory");
}
__device__ __forceinline__ void transpose_item_f8(const float* W, int K, int N, unsigned char* WT, int orow0, int k0, int n0, float scale, LAS float* scr, int lane) {
#pragma unroll 8
    for (int i = 0; i < 64; ++i) { const int kk = 2 * i + (lane >> 5); scr[kk * 33 + (lane & 31)] = W[(size_t)(k0 + kk) * N + n0 + (lane & 31)]; }
    asm volatile("s_waitcnt lgkmcnt(0)" ::: "memory");
    const int c = lane & 7;
#pragma unroll
    for (int j = 0; j < 4; ++j) { const int n = (lane >> 3) + 8 * j; const LAS float* s = scr + (16 * c) * 33 + n;
        u32x4 o; o.x = pk4_fp8(s[0 * 33] * scale, s[1 * 33] * scale, s[2 * 33] * scale, s[3 * 33] * scale); o.y = pk4_fp8(s[4 * 33] * scale, s[5 * 33] * scale, s[6 * 33] * scale, s[7 * 33] * scale);
        o.z = pk4_fp8(s[8 * 33] * scale, s[9 * 33] * scale, s[10 * 33] * scale, s[11 * 33] * scale); o.w = pk4_fp8(s[12 * 33] * scale, s[13 * 33] * scale, s[14 * 33] * scale, s[15 * 33] * scale);
        *(u32x4*)(WT + (size_t)(orow0 + n) * K + k0 + 16 * c) = o; }
    asm volatile("s_waitcnt lgkmcnt(0)" ::: "memory");
}
__device__ __forceinline__ void transpose_item_i8(const float* W, int K, int N, unsigned char* WT, int orow0, int k0, int n0, float scale, LAS float* scr, int lane) {
#pragma unroll 8
    for (int i = 0; i < 64; ++i) { const int kk = 2 * i + (lane >> 5); scr[kk * 33 + (lane & 31)] = W[(size_t)(k0 + kk) * N + n0 + (lane & 31)]; }
    asm volatile("s_waitcnt lgkmcnt(0)" ::: "memory");
    const int c = lane & 7;
#pragma unroll
    for (int j = 0; j < 4; ++j) { const int n = (lane >> 3) + 8 * j; const LAS float* s = scr + (16 * c) * 33 + n;
        u32x4 o; o.x = pk4_i8(s[0 * 33], s[1 * 33], s[2 * 33], s[3 * 33], scale); o.y = pk4_i8(s[4 * 33], s[5 * 33], s[6 * 33], s[7 * 33], scale);
        o.z = pk4_i8(s[8 * 33], s[9 * 33], s[10 * 33], s[11 * 33], scale); o.w = pk4_i8(s[12 * 33], s[13 * 33], s[14 * 33], s[15 * 33], scale);
        *(u32x4*)(WT + (size_t)(orow0 + n) * K + k0 + 16 * c) = o; }
    asm volatile("s_waitcnt lgkmcnt(0)" ::: "memory");
}
__device__ __forceinline__ float wave_max(float v) {
    v = fmaxf(v, swz_xor<1>(v)); v = fmaxf(v, swz_xor<2>(v)); v = fmaxf(v, swz_xor<4>(v)); v = fmaxf(v, swz_xor<8>(v)); v = fmaxf(v, swz_xor<16>(v));
    const auto rr = __builtin_amdgcn_permlane32_swap(__float_as_uint(v), __float_as_uint(v), false, false);
    return fmaxf(__uint_as_float(rr[0]), __uint_as_float(rr[1]));
}
__device__ __forceinline__ void ssq_rows(const float* base, int rows, int N, int stride, unsigned long long* dst, int vb, int G, int tid) {
    const int N4 = N / 4, total = (rows / stride) * N4; float s = 0.f;
    for (int i = vb * 512 + tid; i < total; i += G * 512) { const int r = i / N4, c = i - r * N4; const f32x4 x = ((const f32x4*)(base + (size_t)r * stride * N))[c]; s += (x.x * x.x + x.y * x.y) + (x.z * x.z + x.w * x.w); }
    s = wave_sum(s); if ((tid & 63) == 0) atomicAdd(dst, (unsigned long long)(s * 4294967296.0f));
}
constexpr int I8_S0 = 8, I8_S1 = 8, I8_S2 = 32;
__device__ __forceinline__ void ph_wstats(KP p, int vb, int G, int wv) {
    const int tid = opaque_tid(wv); unsigned* ctl = (unsigned*)(p->ws + WS_CTL); unsigned long long* sq = (unsigned long long*)(ctl + CW_SSQ);
    if (MK_DENSE_I8) { ssq_rows(p->in[20], DM, FF, I8_S0, sq + 0, vb, G, tid); ssq_rows(p->in[21], DM, FF, I8_S0, sq + 0, vb, G, tid); }
    if (MK_I8_GATES) ssq_rows(p->in[3], 2 * DM, DIN, I8_S1, sq + 1, vb, G, tid);
    if (MK_WO_I8) ssq_rows(p->in[17], 2 * DM, DM, I8_S1, sq + 3, vb, G, tid);
    if (MK_BR1_I8) ssq_rows(p->in[15], 2 * DH, DM, I8_S1, sq + 4, vb, G, tid);
    if (MK_I8_MOE) { ssq_rows(p->in[25], 8 * DM, FE, I8_S2, sq + 2, vb, G, tid); ssq_rows(p->in[26], 8 * DM, FE, I8_S2, sq + 2, vb, G, tid); }
    if (vb < 4) { const float* g = vb == 0 ? p->in[1] : (vb == 1 ? p->in[18] : (vb == 2 ? p->in[28] : p->in[18] + DM)); const float* b = vb == 0 ? p->in[2] : (vb == 1 ? p->in[19] : (vb == 2 ? p->in[29] : p->in[19] + DM));
        const float mg = wave_max(fmaxf(fmaxf(fabsf(g[tid]), fabsf(g[tid + 512])), fmaxf(fabsf(g[tid + 1024]), fabsf(g[tid + 1536]))));
        const float mb = wave_max(fmaxf(fmaxf(fabsf(b[tid]), fabsf(b[tid + 512])), fmaxf(fabsf(b[tid + 1024]), fabsf(b[tid + 1536]))));
        if ((tid & 63) == 0) { atomicMax(ctl + CW_AMAX + 2 * vb, __float_as_uint(mg)); atomicMax(ctl + CW_AMAX + 2 * vb + 1, __float_as_uint(mb)); } }
}
__device__ __forceinline__ float ctl_f(KP p, int w) { return __uint_as_float(__hip_atomic_load((unsigned*)(p->ws + WS_CTL) + w, __ATOMIC_RELAXED, __HIP_MEMORY_SCOPE_AGENT)); }
__device__ __forceinline__ float i8_range_a(KP p, int site) { return fmaxf(I8_ACLIP * ctl_f(p, CW_AMAX + 2 * site) + ctl_f(p, CW_AMAX + 2 * site + 1), 1e-30f); }
__device__ __forceinline__ float i8_range_w(KP p, int gid) {
    const unsigned long long v = __hip_atomic_load((unsigned long long*)((unsigned*)(p->ws + WS_CTL) + CW_SSQ) + gid, __ATOMIC_RELAXED, __HIP_MEMORY_SCOPE_AGENT);
    const float cnt = gid == 0 ? 2.0f * (DM / I8_S0) * FF : (gid == 1 ? (2.0f * DM / I8_S1) * DIN : (gid == 3 ? (2.0f * DM / I8_S1) * DM : (gid == 4 ? (2.0f * DH / I8_S1) * DM : 2.0f * (8 * DM / I8_S2) * FE)));
    return fmaxf(I8_WCLIP * sqrtf((float)v * (1.0f / 4294967296.0f) / cnt), 1e-30f);
}
struct TrItem { const float* src; size_t dstb; int ld, K, kbk, mode, d, n0, k0, c0; float sc; };
__device__ __forceinline__ int tr_decode(KP p, int it, float qw0, float qw1, float qw2, float qw3, float qw4, TrItem& I) {
    constexpr int ND = 12;
    constexpr int d_src[ND] = {3, 3, 15, 16, 17, 20, 21, 22, 25, 26, 27, 3};
    constexpr int d_K[ND] = {2048, 2048, 1024, 1024, 2048, 2048, 2048, 5632, 2048, 2048, 7168, 2048};
    constexpr int d_N[ND] = {MK_I8_PROJ == 3 ? (MK_I8_QKV_BF16 == 1 ? O_G - O_Q : (MK_I8_QKV_BF16 == 2 ? O_Q : 0)) : NPB, MK_I8_PROJ == 3 ? 0 : 4096, 2048, 2048, 2048, 5632, 5632, 2048, 7168, 7168, 2048, MK_I8_PROJ ? DIN : 0};
    constexpr int d_ld[ND] = {DIN, DIN, 2048, 2048, 2048, 5632, 5632, 2048, 7168, 7168, 2048, DIN};
    constexpr int d_c0[ND] = {(MK_I8_PROJ == 3 && MK_I8_QKV_BF16 == 1) ? O_Q : 0, NPB, 0, 0, 0, 0, 0, 0, 0, 0, 0, 0};
    constexpr int d_mode[ND] = {0, 0, 0, 0, 0, 1, 2, 0, 1, 2, 0, 0};
    constexpr int d_nb[ND] = {2, 2, 2, 2, 2, 1, 1, 1, 8, 8, 8, 2};
    constexpr int DKB = (MK_DENSE_F8 || MK_DENSE_I8) ? 128 : 64, DKD = (MK_DENSE_F8 || MK_DENSE_DN_F8) ? 128 : 64;
    constexpr int d_kb[ND] = {64, 128, MK_BR1_I8 ? 128 : 64, 64, (MK_WO_F8 || MK_WO_I8) ? 128 : 64, DKB, DKB, DKD, 128, 128, 128, 128};
    constexpr float d_sc[ND] = {1.f, SC_GU, 1.f, 1.f, MK_WO_F8 ? 64.f : 1.f, MK_DENSE_F8 ? SC_GU : 1.f, MK_DENSE_F8 ? SC_GU : 1.f, (MK_DENSE_F8 || MK_DENSE_DN_F8) ? SC_DN : 1.f, SC_GU, SC_GU, SC_DN, 1.f};
    constexpr size_t d_dst[ND] = {WS_WIN, WS_WING, WS_WHB, WS_WAB, WS_WO, WS_WGU, WS_WGU, WS_WD, WS_EGU, WS_EGU, WS_ED, WS_WIN8};
    if (it < 0) { int total = 0;
#pragma unroll
        for (int d = 0; d < ND; ++d) total += d_nb[d] * (d_K[d] / 128) * (d_N[d] / 256);
        return total; }

        int r = it, d = 0;
#pragma unroll
        for (int q = 0; q < ND - 1; ++q) { const int cnt = d_nb[q] * (d_K[q] / 128) * (d_N[q] / 256); if (d == q && r >= cnt) { r -= cnt; d = q + 1; } }
        int K = 0, N = 0, mode = 0, src = 0, kbk = 64, ld = 0, c0 = 0; size_t dst = 0; float sc = 1.f;
#pragma unroll
        for (int q = 0; q < ND; ++q) if (d == q) { K = d_K[q]; N = d_N[q]; mode = d_mode[q]; src = d_src[q]; dst = d_dst[q]; kbk = d_kb[q]; sc = d_sc[q]; ld = d_ld[q]; c0 = d_c0[q]; }
        const int nblk = N / 256, per_b = (K / 128) * nblk, bi = r / per_b, rr = r % per_b, kb = rr / nblk, nbk = rr % nblk;
        const bool i8 = (MK_DENSE_I8 && (d == 5 || d == 6)) || (MK_I8_GATES && d == 1) || (d == 11) || (MK_I8_MOE && (d == 8 || d == 9)) || (MK_WO_I8 && d == 4) || (MK_BR1_I8 && d == 2);
        I.k0 = kb * 128; I.n0 = nbk * 256; I.c0 = c0; I.ld = ld; I.K = K; I.kbk = kbk; I.mode = mode; I.d = i8 ? 100 + d : d;
        I.sc = i8 ? (d == 2 ? qw4 : (d == 4 ? qw3 : ((d == 1 || d == 11) ? qw1 : (d < 8 ? qw0 : qw2)))) : sc;
        I.src = p->in[src] + (size_t)bi * K * ld + c0 + (size_t)I.k0 * ld + I.n0;
        I.dstb = dst + (size_t)bi * (mode ? 2 : 1) * N * K * (kbk == 64 ? 2 : 1);
        return 0;
}
__device__ __forceinline__ void ph_transpose(KP p, LAS unsigned char* lds, int vb, int G, int wv) {
    const int tid = opaque_tid(wv), lane = tid & 63, wave = tid >> 6;
    LAS float* scr = (LAS float*)lds; constexpr int PITCH = 257;
    const float qw0 = MK_DENSE_I8 ? 127.0f / i8_range_w(p, 0) : 0.f, qw1 = MK_I8_GATES ? 127.0f / i8_range_w(p, 1) : 0.f, qw2 = MK_I8_MOE ? 127.0f / i8_range_w(p, 2) : 0.f, qw3 = MK_WO_I8 ? 127.0f / i8_range_w(p, 3) : 0.f, qw4 = MK_BR1_I8 ? 127.0f / i8_range_w(p, 4) : 0.f;
    TrItem dummy; const int total = tr_decode(p, -1, qw0, qw1, qw2, qw3, qw4, dummy);
    float v[16][4];
    auto issue = [&](const TrItem& I) {
#pragma unroll
        for (int j = 0; j < 16; ++j) { const float* rp = I.src + (size_t)(wave + 8 * j) * I.ld + lane;
#pragma unroll
            for (int i = 0; i < 4; ++i) v[j][i] = rp[64 * i]; }
    };
    TrItem cur, nxt; int it = vb;
    if (it < total) { tr_decode(p, it, qw0, qw1, qw2, qw3, qw4, cur); issue(cur); }
    for (; it < total; it += G) {
        __syncthreads();
#pragma unroll
        for (int j = 0; j < 16; ++j)
#pragma unroll
            for (int i = 0; i < 4; ++i) scr[(wave + 8 * j) * PITCH + lane + 64 * i] = v[j][i];
        __syncthreads();
        const bool has_next = it + G < total;
        if (has_next) { tr_decode(p, it + G, qw0, qw1, qw2, qw3, qw4, nxt); issue(nxt); }
        const int dd = cur.d >= 100 ? cur.d - 100 : cur.d; const bool i8 = cur.d >= 100;
        auto orow_of = [&](int n) -> size_t { const int na = cur.n0 + n, nb = na & ~31;
            int o = cur.mode == 0 ? nb : (nb / 128) * 256 + (nb % 128) + (cur.mode == 2 ? 128 : 0);
            if (MK_QK_EPI && (dd == 0 || dd == 11) && nb + cur.c0 >= O_Q && nb + cur.c0 < O_V) o = (nb & ~255) + 128 * ((nb >> 5) & 1) + 32 * ((nb >> 6) & 3);
            return (size_t)(o + (na & 31)); };
        if (cur.kbk == 64) {
#pragma unroll
            for (int j = 0; j < 8; ++j) { const int q = tid + 512 * j, n = q >> 4, c = q & 15; const LAS float* s = scr + (8 * c) * PITCH + n;
                u32x4 w; w.x = pk2(s[0 * PITCH], s[1 * PITCH]); w.y = pk2(s[2 * PITCH], s[3 * PITCH]); w.z = pk2(s[4 * PITCH], s[5 * PITCH]); w.w = pk2(s[6 * PITCH], s[7 * PITCH]);
                *(u32x4*)((bf16*)(p->ws + cur.dstb) + orow_of(n) * cur.K + cur.k0 + 8 * c) = w; }
        } else {
#pragma unroll
            for (int j = 0; j < 4; ++j) { const int q = tid + 512 * j, n = q >> 3, c = q & 7; const LAS float* s = scr + (16 * c) * PITCH + n; const float sc = cur.sc; u32x4 w;
                if (i8) { w.x = pk4_i8(s[0 * PITCH], s[1 * PITCH], s[2 * PITCH], s[3 * PITCH], sc); w.y = pk4_i8(s[4 * PITCH], s[5 * PITCH], s[6 * PITCH], s[7 * PITCH], sc);
                          w.z = pk4_i8(s[8 * PITCH], s[9 * PITCH], s[10 * PITCH], s[11 * PITCH], sc); w.w = pk4_i8(s[12 * PITCH], s[13 * PITCH], s[14 * PITCH], s[15 * PITCH], sc); }
                else { w.x = pk4_fp8(s[0 * PITCH] * sc, s[1 * PITCH] * sc, s[2 * PITCH] * sc, s[3 * PITCH] * sc); w.y = pk4_fp8(s[4 * PITCH] * sc, s[5 * PITCH] * sc, s[6 * PITCH] * sc, s[7 * PITCH] * sc);
                       w.z = pk4_fp8(s[8 * PITCH] * sc, s[9 * PITCH] * sc, s[10 * PITCH] * sc, s[11 * PITCH] * sc); w.w = pk4_fp8(s[12 * PITCH] * sc, s[13 * PITCH] * sc, s[14 * PITCH] * sc, s[15 * PITCH] * sc); }
                *(u32x4*)(p->ws + cur.dstb + orow_of(n) * cur.K + cur.k0 + 16 * c) = w; }
        }
        cur = nxt;
    }
    __syncthreads();
}
__device__ __forceinline__ void ln_row_stats(f32x4 (&v)[8], float& mean, float& rstd) {
    float s = 0.f;
#pragma unroll
    for (int j = 0; j < 8; ++j) s += (v[j].x + v[j].y) + (v[j].z + v[j].w);
    mean = wave_sum(s) * (1.f / DM); float s2 = 0.f;
#pragma unroll
    for (int j = 0; j < 8; ++j) { const f32x4 d = v[j] - mean; s2 += (d.x * d.x + d.y * d.y) + (d.z * d.z + d.w * d.w); }
    rstd = 1.f / sqrtf(wave_sum(s2) * (1.f / DM) + LN_EPS);
}
__device__ __forceinline__ void ph_ln_in(KP p, int vb, int G, int wv) {
    const int tid_ = opaque_tid(wv); const int lane = tid_ & 63, wave = tid_ >> 6; const int gw = vb * 8 + wave, NGW = G * 8;
    const f32x4* g4 = (const f32x4*)p->in[1]; const f32x4* b4 = (const f32x4*)p->in[2];
    bf16* H0 = (bf16*)(p->ws + WS_H0); const float q8 = MK_I8_GATES ? 127.0f / i8_range_a(p, 0) : 0.f;
    for (int m0 = gw; m0 < NT; m0 += 2 * NGW) {
        f32x4 v[2][8];
#pragma unroll
        for (int k = 0; k < 2; ++k) { const int m = m0 + k * NGW; const int mm = m < NT ? m : NT - 1; const f32x4* xr = (const f32x4*)(p->in[0] + (size_t)mm * DM);
#pragma unroll
            for (int j = 0; j < 8; ++j) v[k][j] = xr[lane + 64 * j]; }
#pragma unroll
        for (int k = 0; k < 2; ++k) { const int m = m0 + k * NGW; if (m < NT) {
            float mean, rstd; ln_row_stats(v[k], mean, rstd);
            u32x2* o = (u32x2*)(H0 + (size_t)m * DM); unsigned* o8 = (unsigned*)(p->ws + WS_HF8 + (size_t)m * DM);
#pragma unroll
            for (int j = 0; j < 8; ++j) { const f32x4 g = g4[lane + 64 * j], b = b4[lane + 64 * j]; const f32x4 y = (v[k][j] - mean) * rstd * g + b;
                u32x2 w; w.x = pk2(y.x, y.y); w.y = pk2(y.z, y.w); o[lane + 64 * j] = w; o8[lane + 64 * j] = MK_I8_GATES ? pk4_i8(y.x, y.y, y.z, y.w, q8) : pk4_fp8(y.x, y.y, y.z, y.w); } } }
    }
}
__device__ __forceinline__ void ph_rope(KP p, int vb, int G, int wv) {
    float* ct = (float*)(p->ws + WS_ROPE); float* st = ct + SEQ * 32;
    for (int i = vb * 512 + opaque_tid(wv); i < SEQ * 32; i += G * 512) {
        const int pos = i >> 5, pp = i & 31;
        const double inv = pow(10000.0, -(double)(pp & 15) / 16.0);
        const double ang = (double)(pp < 16 ? (pos >> 6) : (pos & 63)) * inv;
        ct[i] = (float)cos(ang); st[i] = (float)sin(ang);
    }
}
__device__ __forceinline__ void ph_filter(KP p, LAS unsigned char* lds, int vb, int G, int wv) {
    const int tid = opaque_tid(wv);
    LAS float* z = (LAS float*)lds;
    LAS float* a1 = z + 16 * 36;
    LAS float* a2 = a1 + 16 * 64;
    for (int u = vb; u < 256; u += G) {
        const int l = u >> 7, n0 = (u & 127) * 16;
        const float* fw1 = p->in[6] + l * 33 * 64; const float* fb1 = p->in[7] + l * 64; const float* fw2 = p->in[8] + l * 64 * 64; const float* fb2 = p->in[9] + l * 64;
        const float* fw3 = p->in[10] + (size_t)l * 64 * 2048; const float* fr = p->in[11] + l * 128; const float* hb = p->in[12] + l * 1024;
        __syncthreads();
        for (int idx = tid; idx < 16 * 33; idx += 512) { const int pp = idx / 33, i = idx % 33; const int n = n0 + pp; float val;
            if (i == 0) val = (float)n / 2047.0f;
            else { const int j = (i - 1) & 15; const double f = (double)(1e-4f + (float)j * ((15.0f - 1e-4f) / 15.0f)); const double w = 2.0 * 3.14159265358979323846 * (double)n / 2048.0;
                   val = (i <= 16) ? (float)cos(f * w) : -(float)sin(f * w); }
            z[pp * 36 + i] = val; }
        __syncthreads();
        for (int o = tid; o < 1024; o += 512) { const int pp = o >> 6, h = o & 63; float s = fb1[h];
            for (int i = 0; i < 33; ++i) s += z[pp * 36 + i] * fw1[i * 64 + h];
            a1[pp * 64 + h] = sinf(fr[h] * s); }
        __syncthreads();
        for (int o = tid; o < 1024; o += 512) { const int pp = o >> 6, h = o & 63; float s = fb2[h];
            for (int i = 0; i < 64; ++i) s += a1[pp * 64 + i] * fw2[i * 64 + h];
            a2[pp * 64 + h] = sinf(fr[64 + h] * s); }
        __syncthreads();
        const int col4 = tid * 4; f32x4 acc[16];
#pragma unroll
        for (int pp = 0; pp < 16; ++pp) acc[pp] = (f32x4){0.f, 0.f, 0.f, 0.f};
        for (int i = 0; i < 64; ++i) { const f32x4 w4 = *(const f32x4*)(fw3 + (size_t)i * 2048 + col4);
#pragma unroll
            for (int pp = 0; pp < 16; ++pp) acc[pp] += a2[pp * 64 + i] * w4; }
        const bool bwd = col4 >= 1024; const int c0 = col4 & 1023;
        const float mind = -3.0701134573253944f, maxd = -15.350567286626973f;
        bf16* Gd = (bf16*)(p->ws + (bwd ? WS_GB : WS_GF)) + (size_t)l * 1024 * 2048;
#pragma unroll
        for (int j = 0; j < 4; ++j) { const int c = c0 + j; const float delta = fabsf(mind + (float)c * ((maxd - mind) / 1023.0f)); float vals[16];
#pragma unroll
            for (int pp = 0; pp < 16; ++pp) { const int n = n0 + pp; const float tn = (float)n / 2047.0f; float v = acc[pp][j] * expf(-tn * delta);
                if (n == 0) v = bwd ? 0.f : v + hb[c]; vals[pp] = v; }
            u32x4 w0, w1; w0.x = pk2(vals[0], vals[1]); w0.y = pk2(vals[2], vals[3]); w0.z = pk2(vals[4], vals[5]); w0.w = pk2(vals[6], vals[7]);
            w1.x = pk2(vals[8], vals[9]); w1.y = pk2(vals[10], vals[11]); w1.z = pk2(vals[12], vals[13]); w1.w = pk2(vals[14], vals[15]);
            u32x4* dst = (u32x4*)(Gd + (size_t)c * 2048 + n0); dst[0] = w0; dst[1] = w1; }
    }
}
__device__ __forceinline__ void ph_qk_prep(KP p, int layer, int vb, int G, int wv) {
    const int tid_ = opaque_tid(wv); const int lane = tid_ & 63, wave = tid_ >> 6; const int gw = vb * 8 + wave, NGW = G * 8;
    bf16* PROJ = (bf16*)(p->ws + WS_PROJ); const float* ct = (const float*)(p->ws + WS_ROPE); const float* st = ct + SEQ * 32;
    const float* qg = p->in[13] + layer * 64; const float* kg = p->in[14] + layer * 64;
    const int l16 = lane & 15, hsub = lane >> 4;
    for (int m = gw; m < NT; m += NGW) {
        const int pos = m & (SEQ - 1);
        const f32x2 c2 = *(const f32x2*)(ct + pos * 32 + 2 * l16), s2 = *(const f32x2*)(st + pos * 32 + 2 * l16);
#pragma unroll
        for (int g = 0; g < 5; ++g) {
            const int hh = 4 * g + hsub;
            unsigned* base = (unsigned*)(PROJ + (size_t)m * DIN + O_Q + hh * 64);
            const unsigned w1 = base[l16], w2 = base[16 + l16];
            float x0 = bflo(w1), x1 = bfhi(w1), y0 = bflo(w2), y1 = bfhi(w2);
            float ss = x0 * x0 + x1 * x1 + y0 * y0 + y1 * y1;
            ss += swz_xor<1>(ss); ss += swz_xor<2>(ss); ss += swz_xor<4>(ss); ss += swz_xor<8>(ss);
            const float rinv = 1.0f / sqrtf(ss * (1.0f / 64.0f) + RMS_EPS);
            const float* gg = hh < 16 ? qg : kg; const float sc = hh < 16 ? QSCALE : 1.0f;
            const f32x2 ga = *(const f32x2*)(gg + 2 * l16), gb = *(const f32x2*)(gg + 32 + 2 * l16);
            x0 *= rinv * ga.x; x1 *= rinv * ga.y; y0 *= rinv * gb.x; y1 *= rinv * gb.y;
            const float o0 = (x0 * c2.x - y0 * s2.x) * sc, o1 = (x1 * c2.y - y1 * s2.y) * sc, q0 = (y0 * c2.x + x0 * s2.x) * sc, q1 = (y1 * c2.y + x1 * s2.y) * sc;
            base[l16] = pk2(o0, o1); base[16 + l16] = pk2(q0, q1);
        }
    }
}
__device__ __forceinline__ void short_conv_rows(const u32x4 (&raw)[6], bool lo_ok, bool hi_ok, const float* cw, const float* cb, int g, int c0, float (&o)[4][8]) {
    float w0[8], w1[8], w2[8], bb[8];
#pragma unroll
    for (int h = 0; h < 2; ++h) { const f32x4 a = *(const f32x4*)(cw + 0 * 3072 + g * 1024 + c0 + 4 * h), bq = *(const f32x4*)(cw + 1 * 3072 + g * 1024 + c0 + 4 * h), c = *(const f32x4*)(cw + 2 * 3072 + g * 1024 + c0 + 4 * h), d = *(const f32x4*)(cb + g * 1024 + c0 + 4 * h);
#pragma unroll
        for (int e = 0; e < 4; ++e) { w0[4 * h + e] = a[e]; w1[4 * h + e] = bq[e]; w2[4 * h + e] = c[e]; bb[4 * h + e] = d[e]; } }
#pragma unroll
    for (int r = 0; r < 4; ++r)
#pragma unroll
        for (int e = 0; e < 8; ++e) o[r][e] = bb[e];
#pragma unroll
    for (int i = 0; i < 6; ++i) { u32x4 w = raw[i];
        if ((i == 0 && !lo_ok) || (i == 5 && !hi_ok)) w = (u32x4){0u, 0u, 0u, 0u};
        float uu[8]; uu[0] = bflo(w.x); uu[1] = bfhi(w.x); uu[2] = bflo(w.y); uu[3] = bfhi(w.y); uu[4] = bflo(w.z); uu[5] = bfhi(w.z); uu[6] = bflo(w.w); uu[7] = bfhi(w.w);
#pragma unroll
        for (int e = 0; e < 8; ++e) {
            if (i < 4) o[i][e] += w0[e] * uu[e];
            if (i >= 1 && i <= 4) o[i - 1][e] += w1[e] * uu[e];
            if (i >= 2) o[i - 2][e] += w2[e] * uu[e]; } }
}
__device__ __forceinline__ void ph_hy_prep(KP p, int layer, LAS unsigned char* lds, int vb, int G, int wv) {
    const int tid = opaque_tid(wv), cg = tid & 15, rs = tid >> 4;
    const bf16* PROJ = (const bf16*)(p->ws + WS_PROJ); bf16* PT = (bf16*)(p->ws + WS_PT);
    const float* cw = p->in[4] + layer * 3 * 3072; const float* cb = p->in[5] + layer * 3072;
    LAS bf16* tile = (LAS bf16*)lds;
    auto load_u = [&](int u, u32x4 (&raw)[2][6]) {
        const int cblk = u & 7, sblk = (u >> 3) & 15, b = u >> 7; const int c0 = cblk * 128 + cg * 8, s0 = sblk * 128 + rs * 4;
#pragma unroll
        for (int g = 0; g < 2; ++g)
#pragma unroll
            for (int i = 0; i < 6; ++i) { int s = s0 - 1 + i; s = s < 0 ? 0 : (s > SEQ - 1 ? SEQ - 1 : s); raw[g][i] = *(const u32x4*)(PROJ + ((size_t)b * SEQ + s) * DIN + (g + 1) * 1024 + c0); } };
    auto proc_u = [&](int u, const u32x4 (&raw)[2][6]) {
        const int cblk = u & 7, sblk = (u >> 3) & 15, b = u >> 7; const int c0 = cblk * 128 + cg * 8, s0 = sblk * 128 + rs * 4;
        const bool lo_ok = s0 > 0, hi_ok = s0 + 4 < SEQ;
        float o1[4][8], o2[4][8];
        short_conv_rows(raw[0], lo_ok, hi_ok, cw, cb, 1, c0, o1);
        short_conv_rows(raw[1], lo_ok, hi_ok, cw, cb, 2, c0, o2);
        __syncthreads();
#pragma unroll
        for (int e = 0; e < 8; ++e) { u32x2 w; w.x = pk2(o1[0][e] * o2[0][e], o1[1][e] * o2[1][e]); w.y = pk2(o1[2][e] * o2[2][e], o1[3][e] * o2[3][e]);
            *(LAS u32x2*)(tile + (cg * 8 + e) * 136 + rs * 4) = w; }
        __syncthreads();
#pragma unroll
        for (int k = 0; k < 4; ++k) { const int q = tid + 512 * k, ch = q >> 4, part = q & 15;
            const u32x4 w = *(const LAS u32x4*)(tile + ch * 136 + part * 8);
            *(u32x4*)(PT + ((size_t)(cblk * 128 + ch) * NB + b) * SEQ + sblk * 128 + part * 8) = w; } };
    u32x4 ra[2][6], rb[2][6]; int u = vb;
    if (u < 2048) load_u(u, ra);
    for (; u < 2048; u += 2 * G) {
        const bool h1 = u + G < 2048, h2 = u + 2 * G < 2048;
        if (h1) load_u(u + G, rb);
        proc_u(u, ra);
        if (h1) { if (h2) load_u(u + 2 * G, ra); proc_u(u + G, rb); }
    }
}
__device__ __forceinline__ void ph_hy_post(KP p, int layer, LAS unsigned char* lds, int vb, int G, int wv) {
    const int tid = opaque_tid(wv), cg = tid & 15, rs = tid >> 4;
    const bf16* PROJ = (const bf16*)(p->ws + WS_PROJ); bf16* YHY = (bf16*)(p->ws + WS_YHY); const bf16* PT = (const bf16*)(p->ws + WS_PT);
    const float* cw = p->in[4] + layer * 3 * 3072; const float* cb = p->in[5] + layer * 3072;
    LAS bf16* tile = (LAS bf16*)lds;
    auto load_u = [&](int u, u32x4 (&yt)[4], u32x4 (&raw)[6]) {
        const int cblk = u & 7, sblk = (u >> 3) & 15, b = u >> 7; const int c0 = cblk * 128 + cg * 8, s0 = sblk * 128 + rs * 4;
#pragma unroll
        for (int k = 0; k < 4; ++k) { const int q = tid + 512 * k, ch = q >> 4, part = q & 15; yt[k] = *(const u32x4*)(PT + ((size_t)(cblk * 128 + ch) * NB + b) * SEQ + sblk * 128 + part * 8); }
#pragma unroll
        for (int i = 0; i < 6; ++i) { int s = s0 - 1 + i; s = s < 0 ? 0 : (s > SEQ - 1 ? SEQ - 1 : s); raw[i] = *(const u32x4*)(PROJ + ((size_t)b * SEQ + s) * DIN + c0); } };
    auto proc_u = [&](int u, const u32x4 (&yt)[4], const u32x4 (&raw)[6]) {
        const int cblk = u & 7, sblk = (u >> 3) & 15, b = u >> 7; const int c0 = cblk * 128 + cg * 8, s0 = sblk * 128 + rs * 4;
        const bool lo_ok = s0 > 0, hi_ok = s0 + 4 < SEQ;
        __syncthreads();
#pragma unroll
        for (int k = 0; k < 4; ++k) { const int q = tid + 512 * k, ch = q >> 4, part = q & 15; *(LAS u32x4*)(tile + ch * 136 + part * 8) = yt[k]; }
        float o[4][8]; short_conv_rows(raw, lo_ok, hi_ok, cw, cb, 0, c0, o);
        __syncthreads();
#pragma unroll
        for (int r = 0; r < 4; ++r) { float y[8];
#pragma unroll
            for (int e = 0; e < 8; ++e) y[e] = bf2f(tile[(cg * 8 + e) * 136 + rs * 4 + r]);
            u32x4 w; w.x = pk2(o[r][0] * y[0], o[r][1] * y[1]); w.y = pk2(o[r][2] * y[2], o[r][3] * y[3]); w.z = pk2(o[r][4] * y[4], o[r][5] * y[5]); w.w = pk2(o[r][6] * y[6], o[r][7] * y[7]);
            *(u32x4*)(YHY + ((size_t)b * SEQ + s0 + r) * DH + c0) = w; } };
    u32x4 ya[4], xa[6], yb[4], xb[6]; int u = vb;
    if (u < 2048) load_u(u, ya, xa);
    for (; u < 2048; u += 2 * G) {
        const bool h1 = u + G < 2048, h2 = u + 2 * G < 2048;
        if (h1) load_u(u + G, yb, xb);
        proc_u(u, ya, xa);
        if (h1) { if (h2) load_u(u + 2 * G, ya, xa); proc_u(u + G, yb, xb); }
    }
}
__device__ __forceinline__ void ph_hy_post_q(KP p, int layer, LAS unsigned char* lds, int vb, int G, int wv) {
    const int tid = opaque_tid(wv), cg = tid & 15, rs = tid >> 4;
    const bf16* PROJ = (const bf16*)(p->ws + WS_PROJ); unsigned char* Y8 = p->ws + WS_YHY; const bf16* PT = (const bf16*)(p->ws + WS_PT);
    const float* cw = p->in[4] + layer * 3 * 3072; const float* cb = p->in[5] + layer * 3072;
    unsigned* xb = (unsigned*)(p->ws + WS_XBUF + 13 * MiB) + (size_t)layer * NT * 8; float* sa = (float*)(p->ws + WS_XBUF + 15 * MiB);
    unsigned* cnt = (unsigned*)(p->ws + WS_CTL) + CW_PANEL + (6 + 2 * layer) * 8192; unsigned* tmo = (unsigned*)(p->ws + WS_CTL) + CW_TMO;
    LAS bf16* tile = (LAS bf16*)lds;
    float pv[4][8]; int pu = -1;
    auto finish = [&](int u) {
        const int cblk = u & 7, sblk = (u >> 3) & 15, b = u >> 7; const int c0 = cblk * 128 + cg * 8, s0 = sblk * 128 + rs * 4;
        if (wv == 0) { unsigned spins = 0;
            while ((unsigned)__builtin_amdgcn_readfirstlane((int)__hip_atomic_load(cnt + 64 * (b * 16 + sblk), __ATOMIC_RELAXED, __HIP_MEMORY_SCOPE_AGENT)) < 8u) {
                __builtin_amdgcn_s_sleep(1);
                if ((++spins & 255u) == 0u) { if (__hip_atomic_load(tmo, __ATOMIC_RELAXED, __HIP_MEMORY_SCOPE_AGENT) != 0u) break;
                    if (spins > (1u << 20)) { if ((tid & 63) == 0) __hip_atomic_store(tmo, 1u, __ATOMIC_RELAXED, __HIP_MEMORY_SCOPE_AGENT); break; } } }
            __builtin_amdgcn_fence(__ATOMIC_ACQUIRE, "agent"); }
        __syncthreads();
#pragma unroll
        for (int r = 0; r < 4; ++r) { const size_t row = (size_t)b * SEQ + s0 + r;
            float mx = __uint_as_float(__hip_atomic_load(xb + row * 8 + (cg & 7), __ATOMIC_RELAXED, __HIP_MEMORY_SCOPE_AGENT));
            mx = fmaxf(mx, swz_xor<1>(mx)); mx = fmaxf(mx, swz_xor<2>(mx)); mx = fmaxf(mx, swz_xor<4>(mx)); mx = fmaxf(mx, 1e-30f);
            const float q = 127.0f / mx; u32x2 w; w.x = pk4_i8(pv[r][0], pv[r][1], pv[r][2], pv[r][3], q); w.y = pk4_i8(pv[r][4], pv[r][5], pv[r][6], pv[r][7], q);
            *(u32x2*)(Y8 + row * DH + c0) = w; if (cblk == 0 && cg == 0) sa[row] = mx * (1.0f / 127.0f); } };
    for (int u = vb; u < 2048; u += G) {
        const int cblk = u & 7, sblk = (u >> 3) & 15, b = u >> 7; const int c0 = cblk * 128 + cg * 8, s0 = sblk * 128 + rs * 4;
        const bool lo_ok = s0 > 0, hi_ok = s0 + 4 < SEQ;
        u32x4 yt[4], raw[6];
#pragma unroll
        for (int k = 0; k < 4; ++k) { const int q = tid + 512 * k, ch = q >> 4, part = q & 15; yt[k] = *(const u32x4*)(PT + ((size_t)(cblk * 128 + ch) * NB + b) * SEQ + sblk * 128 + part * 8); }
#pragma unroll
        for (int i = 0; i < 6; ++i) { int s = s0 - 1 + i; s = s < 0 ? 0 : (s > SEQ - 1 ? SEQ - 1 : s); raw[i] = *(const u32x4*)(PROJ + ((size_t)b * SEQ + s) * DIN + c0); }
        if (pu >= 0) finish(pu);
        else __syncthreads();
#pragma unroll
        for (int k = 0; k < 4; ++k) { const int q = tid + 512 * k, ch = q >> 4, part = q & 15; *(LAS u32x4*)(tile + ch * 136 + part * 8) = yt[k]; }
        float o[4][8]; short_conv_rows(raw, lo_ok, hi_ok, cw, cb, 0, c0, o);
        __syncthreads();
#pragma unroll
        for (int r = 0; r < 4; ++r) { float mx = 0.f;
#pragma unroll
            for (int e = 0; e < 8; ++e) { const float v = o[r][e] * bf2f(tile[(cg * 8 + e) * 136 + rs * 4 + r]); pv[r][e] = v; mx = fmaxf(mx, fabsf(v)); }
            mx = fmaxf(mx, swz_xor<1>(mx)); mx = fmaxf(mx, swz_xor<2>(mx)); mx = fmaxf(mx, swz_xor<4>(mx)); mx = fmaxf(mx, swz_xor<8>(mx));
            if (cg == 0) __hip_atomic_store(xb + ((size_t)b * SEQ + s0 + r) * 8 + cblk, __float_as_uint(mx), __ATOMIC_RELAXED, __HIP_MEMORY_SCOPE_AGENT); }
        asm volatile("s_waitcnt vmcnt(0)" ::: "memory"); __syncthreads();
        if (tid == 0) __hip_atomic_fetch_add(cnt + 64 * (b * 16 + sblk), 1u, __ATOMIC_RELAXED, __HIP_MEMORY_SCOPE_AGENT);
        pu = u;
    }
    if (pu >= 0) finish(pu);
}
template <bool ROUTER>
__device__ __forceinline__ void ph_ln(KP p, const float* g, const float* b, bf16* Hout, LAS unsigned char* lds, int vb, int G, int wv) {
    const int tid = opaque_tid(wv), lane = tid & 63, wave = tid >> 6;
    const f32x4* g4 = (const f32x4*)g; const f32x4* b4 = (const f32x4*)b; const float* R = p->out;
    LAS float* rw = (LAS float*)lds;
    LAS int* lcnt = (LAS int*)(lds + 65536);
    LAS int* tinfo = (LAS int*)(lds + 65536 + 64);
    unsigned* ctl = (unsigned*)(p->ws + WS_CTL);
    unsigned* TE = (unsigned*)(p->ws + WS_TOK); float* TW = (float*)(TE + NT); int* TP = (int*)(TW + 2 * NT);
    if (ROUTER) { for (int i = tid; i < 2048 * 8; i += 512) rw[i] = p->in[23][i]; }
    for (int blk = vb; blk < NT / 128; blk += G) {
        if (ROUTER) { __syncthreads(); if (tid < 16) lcnt[tid] = 0; __syncthreads(); }
        for (int r = 0; r < 16; ++r) {
            const int lrow = wave * 16 + r; const int m = blk * 128 + lrow;
            const f32x4* xr = (const f32x4*)(R + (size_t)m * DM); f32x4 v[8];
#pragma unroll
            for (int j = 0; j < 8; ++j) v[j] = xr[lane + 64 * j];
            float mean, rstd; ln_row_stats(v, mean, rstd);
            u32x2* o = (u32x2*)(Hout + (size_t)m * DM); unsigned* o8 = (unsigned*)(p->ws + WS_HF8 + (size_t)m * DM);
#pragma unroll
            for (int j = 0; j < 8; ++j) { const f32x4 gg = g4[lane + 64 * j], bb = b4[lane + 64 * j]; v[j] = (v[j] - mean) * rstd * gg + bb;
                u32x2 w; w.x = pk2(v[j].x, v[j].y); w.y = pk2(v[j].z, v[j].w); o[lane + 64 * j] = w; o8[lane + 64 * j] = pk4_fp8(v[j].x, v[j].y, v[j].z, v[j].w); }
            if (ROUTER) {
                float lg[8];
#pragma unroll
                for (int e = 0; e < 8; ++e) lg[e] = 0.f;
#pragma unroll
                for (int j = 0; j < 8; ++j)
#pragma unroll
                    for (int i = 0; i < 4; ++i) { const int col = 4 * (lane + 64 * j) + i; const f32x4 wa = *(const LAS f32x4*)(rw + col * 8), wb = *(const LAS f32x4*)(rw + col * 8 + 4); const float x = v[j][i];
                        lg[0] += x * wa.x; lg[1] += x * wa.y; lg[2] += x * wa.z; lg[3] += x * wa.w; lg[4] += x * wb.x; lg[5] += x * wb.y; lg[6] += x * wb.z; lg[7] += x * wb.w; }
#pragma unroll
                for (int e = 0; e < 8; ++e) lg[e] = wave_sum(lg[e]) + p->in[24][e];
                int e1 = 0; float l1 = lg[0];
#pragma unroll
                for (int e = 1; e < 8; ++e) if (lg[e] > l1) { l1 = lg[e]; e1 = e; }
                int e2 = -1; float l2 = -3.0e38f;
#pragma unroll
                for (int e = 0; e < 8; ++e) if (e != e1 && lg[e] > l2) { l2 = lg[e]; e2 = e; }
                if (lane == 0) { const float w2 = 1.0f / (1.0f + expf(l1 - l2)); const float w1 = 1.0f - w2;
                    const int p1 = atomicAdd((int*)&lcnt[e1], 1), p2 = atomicAdd((int*)&lcnt[e2], 1);
                    tinfo[lrow * 4 + 0] = e1; tinfo[lrow * 4 + 1] = e2; tinfo[lrow * 4 + 2] = p1; tinfo[lrow * 4 + 3] = p2;
                    TW[2 * m] = w1; TW[2 * m + 1] = w2; }
            }
        }
        if (ROUTER) {
            __syncthreads();
            if (tid < 8) lcnt[8 + tid] = (int)atomicAdd(&ctl[CW_CNT + tid], (unsigned)lcnt[tid]);
            __syncthreads();
            if (tid < 128) { const int m = blk * 128 + tid; const int e1 = tinfo[tid * 4], e2 = tinfo[tid * 4 + 1];
                TE[m] = (unsigned)e1 | ((unsigned)e2 << 8); TP[2 * m] = lcnt[8 + e1] + tinfo[tid * 4 + 2]; TP[2 * m + 1] = lcnt[8 + e2] + tinfo[tid * 4 + 3]; }
        }
    }
}
__device__ __forceinline__ void ph_router(KP p, LAS unsigned char* lds, int vb, int G, int wv) {
    const int tid = opaque_tid(wv), lane = tid & 63, wave = tid >> 6;
    LAS float* rw = (LAS float*)lds;
    LAS int* lcnt = (LAS int*)(lds + 65536);
    LAS int* tinfo = (LAS int*)(lds + 65536 + 64);
    unsigned* ctl = (unsigned*)(p->ws + WS_CTL);
    unsigned* TE = (unsigned*)(p->ws + WS_TOK); float* TW = (float*)(TE + NT); int* TP = (int*)(TW + 2 * NT);
    const bf16* H1 = (const bf16*)(p->ws + WS_H1);
    for (int i = tid; i < 2048 * 8; i += 512) rw[i] = p->in[23][i];
    for (int blk = vb; blk < NT / 128; blk += G) {
        __syncthreads(); if (tid < 16) lcnt[tid] = 0; __syncthreads();
        for (int r4 = 0; r4 < 4; ++r4) {
            const int lrow0 = wave * 16 + r4 * 4; const int m0 = blk * 128 + lrow0;
            const u32x2* hp = (const u32x2*)(H1 + (size_t)m0 * DM) + lane;
            u32x2 cur[4], nxt[4];
#pragma unroll
            for (int rr = 0; rr < 4; ++rr) { cur[rr] = hp[rr * 512]; nxt[rr] = cur[rr]; }
            float lg[4][8];
#pragma unroll
            for (int rr = 0; rr < 4; ++rr)
#pragma unroll
                for (int e = 0; e < 8; ++e) lg[rr][e] = 0.f;
#pragma unroll 1
            for (int j = 0; j < 8; ++j) {
                if (j + 1 < 8) {
#pragma unroll
                    for (int rr = 0; rr < 4; ++rr) nxt[rr] = hp[rr * 512 + 64 * (j + 1)]; }
#pragma unroll
                for (int i = 0; i < 4; ++i) { const int col = 4 * (lane + 64 * j) + i; const f32x4 wa = *(const LAS f32x4*)(rw + col * 8), wb = *(const LAS f32x4*)(rw + col * 8 + 4);
#pragma unroll
                    for (int rr = 0; rr < 4; ++rr) { const unsigned w = (i < 2) ? cur[rr].x : cur[rr].y; const float x = (i & 1) ? bfhi(w) : bflo(w);
                        lg[rr][0] += x * wa.x; lg[rr][1] += x * wa.y; lg[rr][2] += x * wa.z; lg[rr][3] += x * wa.w; lg[rr][4] += x * wb.x; lg[rr][5] += x * wb.y; lg[rr][6] += x * wb.z; lg[rr][7] += x * wb.w; } }
#pragma unroll
                for (int rr = 0; rr < 4; ++rr) cur[rr] = nxt[rr];
            }
#pragma unroll
            for (int rr = 0; rr < 4; ++rr) {
                float l8[8];
#pragma unroll
                for (int e = 0; e < 8; ++e) l8[e] = wave_sum(lg[rr][e]) + p->in[24][e];
                int e1 = 0; float l1 = l8[0];
#pragma unroll
                for (int e = 1; e < 8; ++e) if (l8[e] > l1) { l1 = l8[e]; e1 = e; }
                int e2 = -1; float l2 = -3.0e38f;
#pragma unroll
                for (int e = 0; e < 8; ++e) if (e != e1 && l8[e] > l2) { l2 = l8[e]; e2 = e; }
                if (lane == 0) { const int lrow = lrow0 + rr, m = m0 + rr; const float w2 = 1.0f / (1.0f + expf(l1 - l2)); const float w1 = 1.0f - w2;
                    const int p1 = atomicAdd((int*)&lcnt[e1], 1), p2 = atomicAdd((int*)&lcnt[e2], 1);
                    tinfo[lrow * 4 + 0] = e1; tinfo[lrow * 4 + 1] = e2; tinfo[lrow * 4 + 2] = p1; tinfo[lrow * 4 + 3] = p2;
                    TW[2 * m] = w1; TW[2 * m + 1] = w2; }
            }
        }
        __syncthreads();
        if (tid < 8) lcnt[8 + tid] = (int)atomicAdd(&ctl[CW_CNT + tid], (unsigned)lcnt[tid]);
        __syncthreads();
        if (tid < 128) { const int m = blk * 128 + tid; const int e1 = tinfo[tid * 4], e2 = tinfo[tid * 4 + 1];
            TE[m] = (unsigned)e1 | ((unsigned)e2 << 8); TP[2 * m] = lcnt[8 + e1] + tinfo[tid * 4 + 2]; TP[2 * m + 1] = lcnt[8 + e2] + tinfo[tid * 4 + 3]; }
    }
}
__device__ __forceinline__ void ph_gather(KP p, int vb, int G, int wv) {
    const int tid = opaque_tid(wv), lane = tid & 63, wave = tid >> 6; const int gw = vb * 8 + wave, NGW = G * 8;
    unsigned* ctl = (unsigned*)(p->ws + WS_CTL);
    unsigned* TE = (unsigned*)(p->ws + WS_TOK); float* TW = (float*)(TE + NT); int* TP = (int*)(TW + 2 * NT);
    const bf16* H1 = (const bf16*)(p->ws + WS_H1); unsigned char* XG = p->ws + WS_XG;
    int cnt[8], tb[9]; tb[0] = 0;
#pragma unroll
    for (int e = 0; e < 8; ++e) { cnt[e] = (int)ctl[CW_CNT + e]; tb[e + 1] = tb[e] + (cnt[e] + 255) / 256; }
    if (vb == 0) {
        if (tid == 0) { ctl[CW_NTILES] = (unsigned)tb[8]; for (int e = 0; e < 9; ++e) ctl[CW_TBASE + e] = (unsigned)tb[e]; }
        for (int t = tid; t < MAXTILES; t += 512) { int e = 0;
#pragma unroll
            for (int q = 1; q < 8; ++q) if (t >= tb[q]) e = q;
            ctl[CW_TILE_E + t] = (unsigned)e; }
    }
    for (int m0 = gw; m0 < NT; m0 += 4 * NGW) {
        unsigned ee[4]; int pp1[4], pp2[4]; u32x4 w0[4], w1[4];
#pragma unroll
        for (int k = 0; k < 4; ++k) { const int m = m0 + k * NGW; const int mm = m < NT ? m : NT - 1; ee[k] = TE[mm]; pp1[k] = TP[2 * mm]; pp2[k] = TP[2 * mm + 1];
            const u32x4* src = (const u32x4*)(p->ws + WS_HF8 + (size_t)mm * DM); w0[k] = src[lane]; w1[k] = src[lane + 64]; }
#pragma unroll
        for (int k = 0; k < 4; ++k) { const int m = m0 + k * NGW; if (m < NT) {
            const int e1 = ee[k] & 255, e2 = (ee[k] >> 8) & 255; int b1 = 0, b2 = 0;
#pragma unroll
            for (int q = 0; q < 8; ++q) { if (e1 == q) b1 = tb[q]; if (e2 == q) b2 = tb[q]; }
            const int d1 = b1 * 256 + pp1[k], d2 = b2 * 256 + pp2[k];
            u32x4* q1 = (u32x4*)(XG + (size_t)d1 * DM); u32x4* q2 = (u32x4*)(XG + (size_t)d2 * DM);
            q1[lane] = w0[k]; q1[lane + 64] = w1[k]; q2[lane] = w0[k]; q2[lane + 64] = w1[k];
            if (lane == 0) { TP[2 * m] = d1; TP[2 * m + 1] = d2; } } }
    }
#pragma unroll
    for (int e = 0; e < 8; ++e) { const int r0 = tb[e] * 256 + cnt[e], r1 = tb[e + 1] * 256;
        for (int r = r0 + gw; r < r1; r += NGW) { u32x2* q = (u32x2*)(XG + (size_t)r * DM);
#pragma unroll
            for (int j = 0; j < 4; ++j) q[lane + 64 * j] = (u32x2){0u, 0u}; } }
}
__device__ __forceinline__ void ph_combine_ln(KP p, const float* g, const float* b, int vb, int G, int wv) {
    const int tid_ = opaque_tid(wv); const int lane = tid_ & 63, wave = tid_ >> 6; const int gw = vb * 8 + wave, NGW = G * 8;
    unsigned* TE = (unsigned*)(p->ws + WS_TOK); float* TW = (float*)(TE + NT); int* TP = (int*)(TW + 2 * NT);
    const bf16* H1 = (const bf16*)(p->ws + WS_H1); const bf16* YG = (const bf16*)(p->ws + WS_YG);
    const f32x4* g4 = (const f32x4*)g; const f32x4* b4 = (const f32x4*)b;
    float al = ALPHA; asm volatile("" : "+s"(al));
    for (int m0 = gw; m0 < NT; m0 += 2 * NGW) {
        float w1[2], w2[2]; int d1[2], d2[2]; u32x2 hh[2][8], ya[2][8], yc[2][8];
#pragma unroll
        for (int k = 0; k < 2; ++k) { const int m = m0 + k * NGW; const int mm = m < NT ? m : NT - 1; w1[k] = TW[2 * mm]; w2[k] = TW[2 * mm + 1]; d1[k] = TP[2 * mm]; d2[k] = TP[2 * mm + 1]; }
#pragma unroll
        for (int k = 0; k < 2; ++k) { const int m = m0 + k * NGW; const int mm = m < NT ? m : NT - 1;
            const u32x2* hr = (const u32x2*)(H1 + (size_t)mm * DM); const u32x2* y1 = (const u32x2*)(YG + (size_t)d1[k] * DM); const u32x2* y2 = (const u32x2*)(YG + (size_t)d2[k] * DM);
#pragma unroll
            for (int j = 0; j < 8; ++j) { hh[k][j] = hr[lane + 64 * j]; ya[k][j] = y1[lane + 64 * j]; yc[k][j] = y2[lane + 64 * j]; } }
#pragma unroll
        for (int k = 0; k < 2; ++k) { const int m = m0 + k * NGW; if (m < NT) {
            f32x4 v[8];
#pragma unroll
            for (int j = 0; j < 8; ++j) { const u32x2 h = hh[k][j], a = ya[k][j], c = yc[k][j];
                v[j].x = al * bflo(h.x) + w1[k] * bflo(a.x) + w2[k] * bflo(c.x); v[j].y = al * bfhi(h.x) + w1[k] * bfhi(a.x) + w2[k] * bfhi(c.x);
                v[j].z = al * bflo(h.y) + w1[k] * bflo(a.y) + w2[k] * bflo(c.y); v[j].w = al * bfhi(h.y) + w1[k] * bfhi(a.y) + w2[k] * bfhi(c.y); }
            float mean, rstd; ln_row_stats(v, mean, rstd);
            f32x4* o = (f32x4*)(p->out + (size_t)m * DM);
#pragma unroll
            for (int j = 0; j < 8; ++j) o[lane + 64 * j] = (v[j] - mean) * rstd * g4[lane + 64 * j] + b4[lane + 64 * j]; } }
    }
}


namespace pg8 {
constexpr int BM = 256, BK = 64, HALF = 128, HTB = HALF * BK * 2, STAGE_BYTES = 8 * HTB, NXCD = 8, WGM = 8;
__host__ __device__ __forceinline__ int lds_byte(int r, int c) { const int st = (r >> 4) * 2 + (c >> 5), rr = r & 15, cc = c & 31, ob = rr * 64 + cc * 2; return st * 1024 + (ob ^ (((ob >> 9) & 1) << 5)); }
__host__ __device__ __forceinline__ void stage_rc(int b, int& R, int& C) { const int st = b / 1024, sb = b % 1024, swz = sb ^ (((sb >> 9) & 1) << 5); R = (st >> 1) * 16 + swz / 64; C = (st & 1) * 32 + (swz % 64) / 2; }
__host__ __device__ __forceinline__ int perm32(int rho) { const int n = rho >> 4, i = rho & 15; return 8 * (i >> 2) + 4 * n + (i & 3); }

struct Unit { int pm, pn, om, on; };
struct Gemm { const void* A; const void* Bt; int lda, K; float cs = 1.0f; };

__device__ __forceinline__ void tile_map(int L, int nM, int nN, int& pm, int& pn) {
    const int nwg = nM * nN; int wgid = L; { const int q = nwg / NXCD, r = nwg % NXCD, xcd = wgid % NXCD, off = wgid / NXCD; wgid = (xcd < r ? xcd * (q + 1) : r * (q + 1) + (xcd - r) * q) + off; }
    const int nig = WGM * nN, gid = wgid / nig, fm = gid * WGM, gsz = (nM - fm) < WGM ? (nM - fm) : WGM;
    pm = fm + ((wgid % nig) % gsz); pn = (wgid % nig) / gsz;
}
struct StaticOrder {
    int nM, nN, G, c; int on0 = 0, skip_lo = 1 << 30, skip_n = 0;
    __device__ __forceinline__ bool next(int i, Unit& u) const { const int L = i * G + c; if (L >= nM * nN) return false; tile_map(L, nM, nN, u.pm, u.pn); if (u.pn >= skip_lo) u.pn += skip_n; u.om = u.pm; u.on = u.pn + on0; return true; }
};
struct PanelOrder {
    int nM, G, c;
    __device__ __forceinline__ bool next(int i, Unit& u) const { if (i * 32 >= nM) return false; const int j = c >> 3; u.pm = i * 32 + (c & 7) * 4 + (j & 3); u.pn = j >> 2; u.om = u.pm; u.on = u.pn; return true; }
};
struct GroupedOrder {
    int ntl, tile0, nN, G, c; const unsigned* tile_e; bool a_local;
    __device__ __forceinline__ bool next(int i, Unit& u) const { const int L = i * G + c; if (L >= ntl * nN) return false; int pm, pn; tile_map(L, ntl, nN, pm, pn);
        const int e = (int)tile_e[tile0 + pm]; u.pn = e * nN + pn; u.on = pn; u.pm = a_local ? pm : tile0 + pm; u.om = a_local ? tile0 + pm : pm; return true; }
};

__device__ __forceinline__ unsigned cvt_pk_bf16(float lo, float hi) { unsigned r; asm volatile("v_cvt_pk_bf16_f32 %0, %1, %2" : "=v"(r) : "v"(lo), "v"(hi)); return r; }
__device__ __forceinline__ float fast_sigmoid(float x) { return __builtin_amdgcn_rcpf(1.0f + __builtin_amdgcn_exp2f(-1.4426950408889634f * x)); }
#ifndef MK_EPI_PERM
#define MK_EPI_PERM 1
#endif
struct EpiLane { int prow, pchunk, pa; };
__device__ __forceinline__ EpiLane epi_lane(int fr, int fq) { EpiLane e; const int L = fr + 16 * fq;
    if (MK_EPI_PERM) { e.prow = L >> 2; e.pchunk = L & 3; e.pa = ((L >> 2) + 16 * (L & 3)) << 2; } else { e.prow = fr; e.pchunk = fq; e.pa = L << 2; } return e; }
__device__ __forceinline__ unsigned bperm(int pa, unsigned v) { return MK_EPI_PERM ? (unsigned)__builtin_amdgcn_ds_bpermute(pa, (int)v) : v; }
__device__ __forceinline__ float bpermf(int pa, float v) { return MK_EPI_PERM ? __int_as_float(__builtin_amdgcn_ds_bpermute(pa, __float_as_int(v))) : v; }
__device__ __forceinline__ u32x4 bperm4(int pa, u32x4 w) { u32x4 r; r.x = bperm(pa, w.x); r.y = bperm(pa, w.y); r.z = bperm(pa, w.z); r.w = bperm(pa, w.w); return r; }
struct EpiStore {
    static constexpr bool FUSED = false;
    static constexpr int NVM = 16;
    bf16* O; int ldc;
    __device__ __forceinline__ void operator()(const f32x4 (&acc)[2][2][4][2], const Unit& u, int wr, int wc, int fr, int fq) const {
        const EpiLane e = epi_lane(fr, fq); const int row0 = u.om * BM + wr * 64 + e.prow, col0 = u.on * BM + wc * 32 + 8 * e.pchunk;
#pragma unroll
        for (int ai = 0; ai < 2; ++ai)
#pragma unroll
            for (int m = 0; m < 4; ++m) { bf16* rowp = O + (size_t)(row0 + ai * HALF + m * 16) * ldc + col0;
#pragma unroll
                for (int bj = 0; bj < 2; ++bj) { const f32x4 v0 = acc[ai][bj][m][0], v1 = acc[ai][bj][m][1]; u32x4 w; w.x = cvt_pk_bf16(v0[0], v0[1]); w.y = cvt_pk_bf16(v0[2], v0[3]); w.z = cvt_pk_bf16(v1[0], v1[1]); w.w = cvt_pk_bf16(v1[2], v1[3]);
                    *(u32x4*)(rowp + bj * HALF) = bperm4(e.pa, w); } }
    }
};
template <bool ADD> struct EpiGate {
    static constexpr bool FUSED = false;
    static constexpr int NVM = ADD ? 48 : 32;
    const bf16* gate; int ldg; bf16* O; int ldc; unsigned char* O8 = nullptr; const float* sa = nullptr;
    __device__ __forceinline__ void operator()(const f32x4 (&acc)[2][2][4][2], const Unit& u, int wr, int wc, int fr, int fq) const {
        const EpiLane e = epi_lane(fr, fq); const int row0 = u.om * BM + wr * 64 + e.prow, col0 = u.on * BM + wc * 32 + 8 * e.pchunk;
#pragma unroll
        for (int ai = 0; ai < 2; ++ai)
#pragma unroll
            for (int m = 0; m < 4; ++m) { const size_t r = (size_t)(row0 + ai * HALF + m * 16);
#pragma unroll
                for (int bj = 0; bj < 2; ++bj) { const u32x4 g = *(const u32x4*)(gate + r * ldg + col0 + bj * HALF); bf16* op = O + r * ldc + col0 + bj * HALF;
                    float a[8]; const float sr = sa ? sa[r] : 1.0f;
#pragma unroll
                    for (int q = 0; q < 4; ++q) { a[q] = bpermf(e.pa, acc[ai][bj][m][0][q]) * sr; a[4 + q] = bpermf(e.pa, acc[ai][bj][m][1][q]) * sr; }
                    float o[8];
                    o[0] = fast_sigmoid(bflo(g.x)) * a[0]; o[1] = fast_sigmoid(bfhi(g.x)) * a[1]; o[2] = fast_sigmoid(bflo(g.y)) * a[2]; o[3] = fast_sigmoid(bfhi(g.y)) * a[3];
                    o[4] = fast_sigmoid(bflo(g.z)) * a[4]; o[5] = fast_sigmoid(bfhi(g.z)) * a[5]; o[6] = fast_sigmoid(bflo(g.w)) * a[6]; o[7] = fast_sigmoid(bfhi(g.w)) * a[7];
                    if (ADD) { const u32x4 pv = *(const u32x4*)op; o[0] += bflo(pv.x); o[1] += bfhi(pv.x); o[2] += bflo(pv.y); o[3] += bfhi(pv.y); o[4] += bflo(pv.z); o[5] += bfhi(pv.z); o[6] += bflo(pv.w); o[7] += bfhi(pv.w); }
                    if (ADD && O8) { u32x2 w8; w8.x = pk4_fp8(o[0], o[1], o[2], o[3]); w8.y = pk4_fp8(o[4], o[5], o[6], o[7]); *(u32x2*)(O8 + r * DM + col0 + bj * HALF) = w8; }
                    else { u32x4 w; w.x = cvt_pk_bf16(o[0], o[1]); w.y = cvt_pk_bf16(o[2], o[3]); w.z = cvt_pk_bf16(o[4], o[5]); w.w = cvt_pk_bf16(o[6], o[7]);
                    *(u32x4*)op = w; } } }
    }
};
struct EpiRes {
    static constexpr bool FUSED = false;
    static constexpr int NVM = 48;
    const bf16* res; float* R; float s, al;
    __device__ __forceinline__ void operator()(const f32x4 (&acc)[2][2][4][2], const Unit& u, int wr, int wc, int fr, int fq) const {
        const EpiLane e = epi_lane(fr, fq); const int row0 = u.om * BM + wr * 64 + e.prow, col0 = u.on * BM + wc * 32 + 8 * e.pchunk;
#pragma unroll
        for (int ai = 0; ai < 2; ++ai)
#pragma unroll
            for (int m = 0; m < 4; ++m) { const size_t r = (size_t)(row0 + ai * HALF + m * 16);
#pragma unroll
                for (int bj = 0; bj < 2; ++bj) { const u32x4 h = *(const u32x4*)(res + r * DM + col0 + bj * HALF); float* op = R + r * DM + col0 + bj * HALF;
                    float a[8];
#pragma unroll
                    for (int q = 0; q < 4; ++q) { a[q] = bpermf(e.pa, acc[ai][bj][m][0][q]) * s; a[4 + q] = bpermf(e.pa, acc[ai][bj][m][1][q]) * s; }
                    *(f32x4*)op = (f32x4){al * bflo(h.x) + a[0], al * bfhi(h.x) + a[1], al * bflo(h.y) + a[2], al * bfhi(h.y) + a[3]};
                    *(f32x4*)(op + 4) = (f32x4){al * bflo(h.z) + a[4], al * bfhi(h.z) + a[5], al * bflo(h.w) + a[6], al * bfhi(h.w) + a[7]}; } }
    }
};
__device__ __forceinline__ f32x2 swiglu_pk(f32x2 ag, f32x2 au, float c1  , float s2  ) {
    const f32x2 x = ag * c1, t = (ag * s2) * au;
    f32x2 e; e.x = __builtin_amdgcn_exp2f(x.x); e.y = __builtin_amdgcn_exp2f(x.y);
    const f32x2 d = e + 1.0f;
    f32x2 r; r.x = __builtin_amdgcn_rcpf(d.x); r.y = __builtin_amdgcn_rcpf(d.y);
    return t * r;
}
struct EpiSwiglu {
    static constexpr bool FUSED = false;
    static constexpr int NVM = 8;
    bf16* O; int ldc;
    __device__ __forceinline__ void operator()(const f32x4 (&acc)[2][2][4][2], const Unit& u, int wr, int wc, int fr, int fq) const {
        const EpiLane e = epi_lane(fr, fq); const int row0 = u.om * BM + wr * 64 + e.prow, col0 = u.on * HALF + wc * 32 + 8 * e.pchunk;
#pragma unroll
        for (int ai = 0; ai < 2; ++ai)
#pragma unroll
            for (int m = 0; m < 4; ++m) { float o[8];
#pragma unroll
                for (int n = 0; n < 2; ++n)
#pragma unroll
                    for (int q = 0; q < 4; q += 2) { const f32x4 g = acc[ai][0][m][n], up = acc[ai][1][m][n]; const f32x2 r = swiglu_pk((f32x2){g[q], g[q + 1]}, (f32x2){up[q], up[q + 1]}, -1.4426950408889634f, 1.0f); o[4 * n + q] = r.x; o[4 * n + q + 1] = r.y; }
                u32x4 w; w.x = cvt_pk_bf16(o[0], o[1]); w.y = cvt_pk_bf16(o[2], o[3]); w.z = cvt_pk_bf16(o[4], o[5]); w.w = cvt_pk_bf16(o[6], o[7]);
                *(u32x4*)(O + (size_t)(row0 + ai * HALF + m * 16) * ldc + col0) = bperm4(e.pa, w); }
    }
};

#ifndef MK_STAGE_ASM
#define MK_STAGE_ASM 1
#endif
#ifndef MK_KREV
#define MK_KREV 0
#endif
#ifndef MK_KROT
#define MK_KROT 0
#endif
#ifndef MK_LN_FUSE
#define MK_LN_FUSE 1
#endif
#ifndef MK_RELAX_WAIT
#define MK_RELAX_WAIT 1
#endif
__device__ __forceinline__ void glds_saddr(const void* sbase, unsigned voff, unsigned ldsdst) { unsigned keep;
    asm volatile("s_mov_b32 %0, m0\n\ts_mov_b32 m0, %3\n\ts_nop 0\n\tglobal_load_lds_dwordx4 %1, %2\n\ts_mov_b32 m0, %0" : "=&s"(keep) : "v"(voff), "s"(sbase), "s"(ldsdst) : "memory"); }
typedef int i32x8 __attribute__((ext_vector_type(8)));
typedef int i32x4 __attribute__((ext_vector_type(4)));
__device__ __forceinline__ i32x8 cat8(bf16x8 a, bf16x8 b) { const i32x4 x = __builtin_bit_cast(i32x4, a), y = __builtin_bit_cast(i32x4, b); return __builtin_shufflevector(x, y, 0, 1, 2, 3, 4, 5, 6, 7); }
struct EpiGateQ {
    static constexpr bool FUSED = true;
    static constexpr int NVM = 16;
    const bf16* gate; int ldg; const bf16* prev; int ldp; unsigned char* O8; float* sa; unsigned* xb; unsigned* cnt; unsigned* tmo;
    __device__ __forceinline__ void fused(f32x4 (&acc)[2][2][4][2], const Unit& u, int wr, int wc, int fr, int fq, LAS unsigned char* tab, int wid) const {
        LAS float* P = (LAS float*)tab;
        LAS float* S = (LAS float*)(tab + 4096);
        const EpiLane e = epi_lane(fr, fq); const int lane = fr + 16 * fq;
        const int rowl0 = wr * 64 + e.prow, col0 = u.on * BM + wc * 32 + 8 * e.pchunk;
        unsigned go = (unsigned)(((u.om * BM + rowl0) * ldg + col0) * 2); asm volatile("" : "+v"(go));
#pragma unroll
        for (int ai = 0; ai < 2; ++ai) { u32x4 gq[4][2], pq[4][2];
#pragma unroll
            for (int m = 0; m < 4; ++m)
#pragma unroll
                for (int bj = 0; bj < 2; ++bj) { const unsigned o2 = go + (unsigned)(((ai * HALF + m * 16) * ldg + bj * HALF) * 2); gq[m][bj] = *(const u32x4*)((const char*)gate + o2); pq[m][bj] = *(const u32x4*)((const char*)prev + o2); }
            __builtin_amdgcn_sched_barrier(0);
#pragma unroll
            for (int m = 0; m < 4; ++m) {
#pragma unroll
                for (int bj = 0; bj < 2; ++bj) { const u32x4 g = gq[m][bj], pv = pq[m][bj]; float a[8];
#pragma unroll
                    for (int q = 0; q < 4; ++q) { a[q] = bpermf(e.pa, acc[ai][bj][m][0][q]); a[4 + q] = bpermf(e.pa, acc[ai][bj][m][1][q]); }
                    acc[ai][bj][m][0] = (f32x4){fast_sigmoid(bflo(g.x)) * a[0] + bflo(pv.x), fast_sigmoid(bfhi(g.x)) * a[1] + bfhi(pv.x), fast_sigmoid(bflo(g.y)) * a[2] + bflo(pv.y), fast_sigmoid(bfhi(g.y)) * a[3] + bfhi(pv.y)};
                    acc[ai][bj][m][1] = (f32x4){fast_sigmoid(bflo(g.z)) * a[4] + bflo(pv.z), fast_sigmoid(bfhi(g.z)) * a[5] + bfhi(pv.z), fast_sigmoid(bflo(g.w)) * a[6] + bflo(pv.w), fast_sigmoid(bfhi(g.w)) * a[7] + bfhi(pv.w)}; } }
            { float tie = acc[ai][1][3][1][3]; asm volatile("" : "+v"(go), "+v"(tie)); acc[ai][1][3][1][3] = tie; }
            __builtin_amdgcn_sched_barrier(0); }
#pragma unroll
        for (int ai = 0; ai < 2; ++ai)
#pragma unroll
            for (int m = 0; m < 4; ++m) { float mx = 0.f;
#pragma unroll
                for (int bj = 0; bj < 2; ++bj)
#pragma unroll
                    for (int n = 0; n < 2; ++n) { const f32x4 x = acc[ai][bj][m][n]; mx = fmaxf(mx, fmaxf(fmaxf(fabsf(x[0]), fabsf(x[1])), fmaxf(fabsf(x[2]), fabsf(x[3])))); }
                mx = fmaxf(mx, swz_xor<1>(mx)); mx = fmaxf(mx, swz_xor<2>(mx));
                P[(rowl0 + ai * HALF + m * 16) * 4 + wc] = mx; }
        asm volatile("s_waitcnt lgkmcnt(0)" ::: "memory"); __builtin_amdgcn_s_barrier(); asm volatile("" ::: "memory");
        const int row = wid * 32 + (lane & 31);
        if (lane < 32) { const float tm = fmaxf(fmaxf(P[row * 4 + 0], P[row * 4 + 1]), fmaxf(P[row * 4 + 2], P[row * 4 + 3]));
            __hip_atomic_store(xb + ((size_t)(u.om * BM + row) * 8 + u.on), __float_as_uint(tm), __ATOMIC_RELAXED, __HIP_MEMORY_SCOPE_AGENT); }
        asm volatile("s_waitcnt vmcnt(0)" ::: "memory");
        if (lane == 0) __hip_atomic_fetch_add(cnt + 64 * u.om, 1u, __ATOMIC_RELAXED, __HIP_MEMORY_SCOPE_AGENT);
        if (wid == 0) {
            unsigned spins = 0;
            while ((unsigned)__builtin_amdgcn_readfirstlane((int)__hip_atomic_load(cnt + 64 * u.om, __ATOMIC_RELAXED, __HIP_MEMORY_SCOPE_AGENT)) < 64u) {
                __builtin_amdgcn_s_sleep(1);
                if ((++spins & 255u) == 0u) { if (__hip_atomic_load(tmo, __ATOMIC_RELAXED, __HIP_MEMORY_SCOPE_AGENT) != 0u) break;
                    if (spins > (1u << 20)) { if (lane == 0) __hip_atomic_store(tmo, 1u, __ATOMIC_RELAXED, __HIP_MEMORY_SCOPE_AGENT); break; } } }
            __builtin_amdgcn_fence(__ATOMIC_ACQUIRE, "agent");
        }
        asm volatile("s_waitcnt vmcnt(0) lgkmcnt(0)" ::: "memory"); __builtin_amdgcn_s_barrier(); asm volatile("" ::: "memory");
        if (lane < 32) { const unsigned* slot = xb + (size_t)(u.om * BM + row) * 8; float mx = 1e-30f;
#pragma unroll
            for (int k = 0; k < 8; ++k) mx = fmaxf(mx, __uint_as_float(__hip_atomic_load(slot + k, __ATOMIC_RELAXED, __HIP_MEMORY_SCOPE_AGENT)));
            S[row] = 127.0f / mx; if (u.on == 0) sa[u.om * BM + row] = mx * (1.0f / 127.0f); }
        asm volatile("s_waitcnt lgkmcnt(0)" ::: "memory"); __builtin_amdgcn_s_barrier(); asm volatile("" ::: "memory");
        unsigned eo = (unsigned)((u.om * BM + rowl0) * DM + col0); asm volatile("" : "+v"(eo));
#pragma unroll
        for (int bj = 0; bj < 2; ++bj)
#pragma unroll
            for (int ai = 0; ai < 2; ++ai)
#pragma unroll
                for (int m = 0; m < 4; ++m) { const float q = S[rowl0 + ai * HALF + m * 16]; const f32x4 y0 = acc[ai][bj][m][0], y1 = acc[ai][bj][m][1];
                    u32x2 w8; w8.x = pk4_i8(y0[0], y0[1], y0[2], y0[3], q); w8.y = pk4_i8(y1[0], y1[1], y1[2], y1[3], q);
                    *(u32x2*)(O8 + (eo + (unsigned)((ai * HALF + m * 16) * DM + bj * HALF))) = w8; }
    }
};
struct EpiSwigluF8 {
    static constexpr bool FUSED = false;
    static constexpr int NVM = 8;
    unsigned char* O; int ldc; float s;
    __device__ __forceinline__ void operator()(const f32x4 (&acc)[2][2][4][2], const Unit& u, int wr, int wc, int fr, int fq) const {
        const EpiLane e = epi_lane(fr, fq); const int row0 = u.om * BM + wr * 64 + e.prow, col0 = u.on * HALF + wc * 32 + 8 * e.pchunk;
#pragma unroll
        for (int ai = 0; ai < 2; ++ai)
#pragma unroll
            for (int m = 0; m < 4; ++m) { float o[8];
#pragma unroll
                for (int n = 0; n < 2; ++n)
#pragma unroll
                    for (int q = 0; q < 4; q += 2) { const f32x4 g = acc[ai][0][m][n], up = acc[ai][1][m][n]; const f32x2 r = swiglu_pk((f32x2){g[q], g[q + 1]}, (f32x2){up[q], up[q + 1]}, -1.4426950408889634f * s, s * s); o[4 * n + q] = r.x; o[4 * n + q + 1] = r.y; }
                u32x2 w; w.x = bperm(e.pa, pk4_fp8(o[0], o[1], o[2], o[3])); w.y = bperm(e.pa, pk4_fp8(o[4], o[5], o[6], o[7]));
                *(u32x2*)(O + (size_t)(row0 + ai * HALF + m * 16) * ldc + col0) = w; }
    }
};
struct EpiStoreScaled {
    static constexpr bool FUSED = false;
    static constexpr int NVM = 16;
    bf16* O; int ldc; float s;
    __device__ __forceinline__ void operator()(const f32x4 (&acc)[2][2][4][2], const Unit& u, int wr, int wc, int fr, int fq) const {
        const EpiLane e = epi_lane(fr, fq); const int row0 = u.om * BM + wr * 64 + e.prow, col0 = u.on * BM + wc * 32 + 8 * e.pchunk;
#pragma unroll
        for (int ai = 0; ai < 2; ++ai)
#pragma unroll
            for (int m = 0; m < 4; ++m) { bf16* rowp = O + (size_t)(row0 + ai * HALF + m * 16) * ldc + col0;
#pragma unroll
                for (int bj = 0; bj < 2; ++bj) { const f32x4 v0 = acc[ai][bj][m][0] * s, v1 = acc[ai][bj][m][1] * s; u32x4 w; w.x = cvt_pk_bf16(v0[0], v0[1]); w.y = cvt_pk_bf16(v0[2], v0[3]); w.z = cvt_pk_bf16(v1[0], v1[1]); w.w = cvt_pk_bf16(v1[2], v1[3]);
                    *(u32x4*)(rowp + bj * HALF) = bperm4(e.pa, w); } }
    }
};

struct EpiProj {
    static constexpr bool FUSED = false;
    static constexpr int NVM = 16;
    bf16* O; int ldc; const float* qg; const float* kg; const float* ct; const float* st;
    __device__ __forceinline__ void operator()(const f32x4 (&acc)[2][2][4][2], const Unit& u, int wr, int wc, int fr, int fq) const {
        const EpiLane e = epi_lane(fr, fq);
        if (u.on < O_Q / BM || u.on >= O_V / BM) {
            const int row0 = u.om * BM + wr * 64 + e.prow, col0 = u.on * BM + wc * 32 + 8 * e.pchunk;
#pragma unroll
            for (int ai = 0; ai < 2; ++ai)
#pragma unroll
                for (int m = 0; m < 4; ++m) { bf16* rowp = O + (size_t)(row0 + ai * HALF + m * 16) * ldc + col0;
#pragma unroll
                    for (int bj = 0; bj < 2; ++bj) { const f32x4 v0 = acc[ai][bj][m][0], v1 = acc[ai][bj][m][1]; u32x4 w; w.x = cvt_pk_bf16(v0[0], v0[1]); w.y = cvt_pk_bf16(v0[2], v0[3]); w.z = cvt_pk_bf16(v1[0], v1[1]); w.w = cvt_pk_bf16(v1[2], v1[3]);
                        *(u32x4*)(rowp + bj * HALF) = bperm4(e.pa, w); } }
            return;
        }
        const bool isq = u.on < O_K / BM; const float* gg = isq ? qg : kg; const float sc = isq ? QSCALE : 1.0f;
        const int d0 = 8 * e.pchunk;
        const f32x4 ga0 = *(const f32x4*)(gg + d0), ga1 = *(const f32x4*)(gg + d0 + 4), gb0 = *(const f32x4*)(gg + 32 + d0), gb1 = *(const f32x4*)(gg + 32 + d0 + 4);
        const int row0 = u.om * BM + wr * 64 + e.prow, col0 = u.on * BM + wc * 64 + d0;
#pragma unroll
        for (int ai = 0; ai < 2; ++ai)
#pragma unroll
            for (int m = 0; m < 4; ++m) { const int row = row0 + ai * HALF + m * 16; const int pos = row & (SEQ - 1);
                f32x4 x0, x1, y0, y1;
#pragma unroll
                for (int q = 0; q < 4; ++q) { x0[q] = bpermf(e.pa, acc[ai][0][m][0][q]); x1[q] = bpermf(e.pa, acc[ai][0][m][1][q]); y0[q] = bpermf(e.pa, acc[ai][1][m][0][q]); y1[q] = bpermf(e.pa, acc[ai][1][m][1][q]); }
                const f32x4 c0 = *(const f32x4*)(ct + pos * 32 + d0), c1 = *(const f32x4*)(ct + pos * 32 + d0 + 4), s0 = *(const f32x4*)(st + pos * 32 + d0), s1 = *(const f32x4*)(st + pos * 32 + d0 + 4);
                float ss = 0.f;
#pragma unroll
                for (int q = 0; q < 4; ++q) ss += x0[q] * x0[q] + x1[q] * x1[q] + y0[q] * y0[q] + y1[q] * y1[q];
                ss += swz_xor<1>(ss); ss += swz_xor<2>(ss);
                const float rinv = 1.0f / sqrtf(ss * (1.0f / 64.0f) + RMS_EPS);
                x0 = x0 * rinv * ga0; x1 = x1 * rinv * ga1; y0 = y0 * rinv * gb0; y1 = y1 * rinv * gb1;
                const f32x4 o0 = (x0 * c0 - y0 * s0) * sc, o1 = (x1 * c1 - y1 * s1) * sc, p0 = (y0 * c0 + x0 * s0) * sc, p1 = (y1 * c1 + x1 * s1) * sc;
                bf16* rowp = O + (size_t)row * ldc + col0;
                u32x4 w; w.x = cvt_pk_bf16(o0[0], o0[1]); w.y = cvt_pk_bf16(o0[2], o0[3]); w.z = cvt_pk_bf16(o1[0], o1[1]); w.w = cvt_pk_bf16(o1[2], o1[3]);
                *(u32x4*)rowp = w;
                w.x = cvt_pk_bf16(p0[0], p0[1]); w.y = cvt_pk_bf16(p0[2], p0[3]); w.z = cvt_pk_bf16(p1[0], p1[1]); w.w = cvt_pk_bf16(p1[2], p1[3]);
                *(u32x4*)(rowp + 32) = w; }
    }
};

struct EpiResLn {
    static constexpr bool FUSED = true;
    static constexpr int NVM = 16;
    const bf16* res; bf16* H; unsigned char* H8; const float* g; const float* b; float s, al; unsigned long long* xbuf; unsigned* cnt; unsigned* tmo; float q8 = 0.f; const float* sa = nullptr;
    __device__ __forceinline__ void fused(f32x4 (&acc)[2][2][4][2], const Unit& u, int wr, int wc, int fr, int fq, LAS unsigned char* tab, int wid) const {
        typedef float f32x2v __attribute__((ext_vector_type(2)));
        LAS f32x2v* P = (LAS f32x2v*)tab;
        LAS f32x2v* S = (LAS f32x2v*)(tab + 8192);
        const EpiLane e = epi_lane(fr, fq); const int lane = fr + 16 * fq;
        const int rowl0 = wr * 64 + e.prow, col0 = u.on * BM + wc * 32 + 8 * e.pchunk;
        const unsigned eoff = (unsigned)(((u.om * BM + rowl0) * DM + col0) * 2);
#pragma unroll
        for (int ai = 0; ai < 2; ++ai)
#pragma unroll
            for (int m = 0; m < 4; ++m) { const float sr = sa ? s * sa[u.om * BM + rowl0 + ai * HALF + m * 16] : s;
#pragma unroll
                for (int bj = 0; bj < 2; ++bj) { const u32x4 hh = *(const u32x4*)((const char*)res + (eoff + (unsigned)(((ai * HALF + m * 16) * DM + bj * HALF) * 2))); f32x4 a0, a1;
#pragma unroll
                    for (int q = 0; q < 4; ++q) { a0[q] = bpermf(e.pa, acc[ai][bj][m][0][q]) * sr; a1[q] = bpermf(e.pa, acc[ai][bj][m][1][q]) * sr; }
                    acc[ai][bj][m][0] = (f32x4){al * bflo(hh.x) + a0[0], al * bfhi(hh.x) + a0[1], al * bflo(hh.y) + a0[2], al * bfhi(hh.y) + a0[3]};
                    acc[ai][bj][m][1] = (f32x4){al * bflo(hh.z) + a1[0], al * bfhi(hh.z) + a1[1], al * bflo(hh.w) + a1[2], al * bfhi(hh.w) + a1[3]}; } }
#pragma unroll
        for (int ai = 0; ai < 2; ++ai)
#pragma unroll
            for (int m = 0; m < 4; ++m) { float sm = 0.f;
#pragma unroll
                for (int bj = 0; bj < 2; ++bj)
#pragma unroll
                    for (int n = 0; n < 2; ++n) { const f32x4 x = acc[ai][bj][m][n]; sm += (x[0] + x[1]) + (x[2] + x[3]); }
                sm += swz_xor<1>(sm); sm += swz_xor<2>(sm);
                const float mw = sm * (1.0f / 64.0f); float q2 = 0.f;
#pragma unroll
                for (int bj = 0; bj < 2; ++bj)
#pragma unroll
                    for (int n = 0; n < 2; ++n) { const f32x4 d = acc[ai][bj][m][n] - mw; q2 += (d[0] * d[0] + d[1] * d[1]) + (d[2] * d[2] + d[3] * d[3]); }
                q2 += swz_xor<1>(q2); q2 += swz_xor<2>(q2);
                if (e.pchunk == 0) P[(rowl0 + ai * HALF + m * 16) * 4 + wc] = (f32x2v){mw, q2}; }
        asm volatile("s_waitcnt lgkmcnt(0)" ::: "memory"); __builtin_amdgcn_s_barrier(); asm volatile("" ::: "memory");
        const int row = wid * 32 + (lane & 31);
        if (lane < 32) {
            const f32x2v a = P[row * 4 + 0], bq = P[row * 4 + 1], c = P[row * 4 + 2], d = P[row * 4 + 3];
            const float mt = (a.x + bq.x + c.x + d.x) * 0.25f; const float da = a.x - mt, db = bq.x - mt, dc = c.x - mt, dd = d.x - mt;
            const float m2 = (a.y + bq.y) + (c.y + d.y) + 64.0f * ((da * da + db * db) + (dc * dc + dd * dd));
            __hip_atomic_store(xbuf + ((size_t)(u.om * BM + row) * 8 + u.on), ((unsigned long long)__float_as_uint(m2) << 32) | __float_as_uint(mt), __ATOMIC_RELAXED, __HIP_MEMORY_SCOPE_AGENT);
        }
        asm volatile("s_waitcnt vmcnt(0)" ::: "memory");
        if (lane == 0) __hip_atomic_fetch_add(cnt + 64 * u.om, 1u, __ATOMIC_RELAXED, __HIP_MEMORY_SCOPE_AGENT);
        if (wid == 0) {
            unsigned spins = 0;
            while ((unsigned)__builtin_amdgcn_readfirstlane((int)__hip_atomic_load(cnt + 64 * u.om, __ATOMIC_RELAXED, __HIP_MEMORY_SCOPE_AGENT)) < 64u) {
                __builtin_amdgcn_s_sleep(1);
                if ((++spins & 255u) == 0u) { if (__hip_atomic_load(tmo, __ATOMIC_RELAXED, __HIP_MEMORY_SCOPE_AGENT) != 0u) break;
                    if (spins > (1u << 20)) { if (lane == 0) __hip_atomic_store(tmo, 1u, __ATOMIC_RELAXED, __HIP_MEMORY_SCOPE_AGENT); break; } } }
            __builtin_amdgcn_fence(__ATOMIC_ACQUIRE, "agent");
        }
        asm volatile("s_waitcnt vmcnt(0) lgkmcnt(0)" ::: "memory"); __builtin_amdgcn_s_barrier(); asm volatile("" ::: "memory");
        if (lane < 32) {
            const unsigned long long* slot = xbuf + (size_t)(u.om * BM + row) * 8; float mt[8], m2[8]; float ms = 0.f;
#pragma unroll
            for (int k = 0; k < 8; ++k) { const unsigned long long w = __hip_atomic_load(slot + k, __ATOMIC_RELAXED, __HIP_MEMORY_SCOPE_AGENT); mt[k] = __uint_as_float((unsigned)w); m2[k] = __uint_as_float((unsigned)(w >> 32)); ms += mt[k]; }
            const float mean = ms * 0.125f; float q = 0.f;
#pragma unroll
            for (int k = 0; k < 8; ++k) { const float dm = mt[k] - mean; q += m2[k] + 256.0f * dm * dm; }
            S[row] = (f32x2v){mean, 1.0f / sqrtf(q * (1.0f / 2048.0f) + LN_EPS)};
        }
        asm volatile("s_waitcnt lgkmcnt(0)" ::: "memory"); __builtin_amdgcn_s_barrier(); asm volatile("" ::: "memory");
        unsigned eoff2 = eoff, coff = (unsigned)col0 * 4u; asm volatile("" : "+v"(eoff2), "+v"(coff));
#pragma unroll
        for (int bj = 0; bj < 2; ++bj) {
            const f32x4 g0 = *(const f32x4*)((const char*)g + (coff + bj * HALF * 4)), g1 = *(const f32x4*)((const char*)g + (coff + bj * HALF * 4 + 16)), b0 = *(const f32x4*)((const char*)b + (coff + bj * HALF * 4)), b1 = *(const f32x4*)((const char*)b + (coff + bj * HALF * 4 + 16));
#pragma unroll
            for (int ai = 0; ai < 2; ++ai)
#pragma unroll
                for (int m = 0; m < 4; ++m) { const int rl = rowl0 + ai * HALF + m * 16; const f32x2v sr = S[rl]; const unsigned o2 = eoff2 + (unsigned)(((ai * HALF + m * 16) * DM + bj * HALF) * 2);
                    const f32x4 y0 = (acc[ai][bj][m][0] - sr.x) * sr.y * g0 + b0, y1 = (acc[ai][bj][m][1] - sr.x) * sr.y * g1 + b1;
                    u32x4 w; w.x = cvt_pk_bf16(y0[0], y0[1]); w.y = cvt_pk_bf16(y0[2], y0[3]); w.z = cvt_pk_bf16(y1[0], y1[1]); w.w = cvt_pk_bf16(y1[2], y1[3]);
                    *(u32x4*)((char*)H + o2) = w;
                    if (H8) { u32x2 w8; if (q8 != 0.f) { w8.x = pk4_i8(y0[0], y0[1], y0[2], y0[3], q8); w8.y = pk4_i8(y1[0], y1[1], y1[2], y1[3], q8); } else { w8.x = pk4_fp8(y0[0], y0[1], y0[2], y0[3]); w8.y = pk4_fp8(y1[0], y1[1], y1[2], y1[3]); } *(u32x2*)(H8 + (o2 >> 1)) = w8; } }
        }
    }
};

template <class Epi, class Sched, bool ALIGN_EPI, bool SP2, int EB = 2, bool I8 = false>
__device__ __forceinline__ void gemm_phase(LAS unsigned char* lds, const Gemm g, const Sched& S, const Epi& E, int wv) {
    const int tid = opaque_tid(wv),
        wid = __builtin_amdgcn_readfirstlane(tid >> 6), lane = tid & 63, wr = wid >> 2, wc = wid & 3, fr = lane & 15, fq = lane >> 4;
    const int K = g.K * EB, nt = K / (BK * 2), lda = g.lda * EB;
    unsigned voffA[2], voffB[2];
#pragma unroll
    for (int i = 0; i < 2; ++i) { int R, C; stage_rc(tid * 16 + i * 8192, R, C); const int Rb = (R & ~31) + perm32(R & 31);
        voffA[i] = (unsigned)(R * lda + C * 2); voffB[i] = (unsigned)(Rb * K + C * 2); }
    const size_t kstep = (size_t)(BK * 2);
    const int rot = MK_KROT ? 2 * (((S.c >> 3) + (S.c >> 6)) % (nt / 2)) : 0;
#define PG8_KOFF(tt) ((size_t)(MK_KREV ? (rev ? nt - 1 - (tt) : (tt)) : (((tt) + rot) >= nt ? ((tt) + rot - nt) : ((tt) + rot))) * kstep)
#define PG8_KOFN(tt) ((size_t)(MK_KREV ? (rev ? (tt) : nt - 1 - (tt)) : (((tt) + rot) >= nt ? ((tt) + rot - nt) : ((tt) + rot))) * kstep)
    bool rev = false;
    const size_t hstepA = (size_t)HALF * lda, hstepB = (size_t)HALF * K;
    const size_t tstepA = 2 * hstepA, tstepB = 2 * hstepB;
    const unsigned ldsw = (unsigned)wid * 1024u;
    const unsigned lds_u = (unsigned)(uintptr_t)lds; (void)lds_u;
    const int aoff = lds_byte(wr * 64 + fr, fq * 8), boff = lds_byte(wc * 32 + fr, fq * 8);
#define PG8_SA(b, h) (((b) * 2 + (h)) * HTB)
#define PG8_SB(b, h) ((4 + (b) * 2 + (h)) * HTB)
#if MK_STAGE_ASM
#define PG8_STAGE(bufoff, gbase, voff) do { _Pragma("unroll") for (int _i = 0; _i < 2; ++_i) \
        glds_saddr((const void*)(gbase), (voff)[_i], (unsigned)__builtin_amdgcn_readfirstlane((int)(lds_u + (unsigned)(bufoff) + ldsw + _i * 8192))); } while (0)
#else
#define PG8_STAGE(bufoff, gbase, voff) do { _Pragma("unroll") for (int _i = 0; _i < 2; ++_i) \
        __builtin_amdgcn_global_load_lds((const unsigned*)((const char*)(gbase) + (voff)[_i]), (LAS unsigned*)(lds + (bufoff) + ldsw + _i * 8192), 16, 0, 0); } while (0)
#endif
#define PG8_LDA(dst, b, h) do { _Pragma("unroll") for (int m = 0; m < 4; ++m) _Pragma("unroll") for (int k = 0; k < 2; ++k) dst[m][k] = *(const LAS bf16x8*)(lds + PG8_SA(b, h) + aoff + m * 2048 + k * 1024); } while (0)
#define PG8_LDB(dst, b, h) do { _Pragma("unroll") for (int n = 0; n < 2; ++n) _Pragma("unroll") for (int k = 0; k < 2; ++k) dst[n][k] = *(const LAS bf16x8*)(lds + PG8_SB(b, h) + boff + n * 2048 + k * 1024); } while (0)
#define PG8_MMA(ai, bj, At, Bt) do { __builtin_amdgcn_s_setprio(1); _Pragma("unroll") for (int m = 0; m < 4; ++m) _Pragma("unroll") for (int n = 0; n < 2; ++n) { \
        if constexpr (EB == 2) { _Pragma("unroll") for (int k = 0; k < 2; ++k) acc[ai][bj][m][n] = __builtin_amdgcn_mfma_f32_16x16x32_bf16(Bt[n][k], At[m][k], acc[ai][bj][m][n], 0, 0, 0); } \
        else if constexpr (I8) { _Pragma("unroll") for (int k = 0; k < 2; ++k) acc[ai][bj][m][n] = __builtin_bit_cast(f32x4, __builtin_amdgcn_mfma_i32_16x16x64_i8(__builtin_bit_cast(i32x4, Bt[n][k]), __builtin_bit_cast(i32x4, At[m][k]), __builtin_bit_cast(i32x4, acc[ai][bj][m][n]), 0, 0, 0)); }   \
        else acc[ai][bj][m][n] = __builtin_amdgcn_mfma_scale_f32_16x16x128_f8f6f4(cat8(Bt[n][0], Bt[n][1]), cat8(At[m][0], At[m][1]), acc[ai][bj][m][n], 0, 0, 0, 0, 0, 0); }   \
        __builtin_amdgcn_s_setprio(0); } while (0)
#define PG8_WAIT_V(n) asm volatile("s_waitcnt vmcnt(" #n ")" ::: "memory")
#define PG8_WAIT_L(n) asm volatile("s_waitcnt lgkmcnt(" #n ")" ::: "memory")
#define PG8_BAR __builtin_amdgcn_s_barrier()
#define PG8_SCHED __builtin_amdgcn_sched_barrier(0)
    Unit cur, nxt; int ui = 0;
    if (!S.next(0, cur)) return;
    f32x4 acc[2][2][4][2];
#pragma unroll
    for (int a = 0; a < 2; ++a)
#pragma unroll
        for (int b = 0; b < 2; ++b)
#pragma unroll
            for (int m = 0; m < 4; ++m)
#pragma unroll
                for (int n = 0; n < 2; ++n) acc[a][b][m][n] = (f32x4){0.f, 0.f, 0.f, 0.f};
    bf16x8 At[4][2], B0[2][2], B1[2][2];
    const char* cA = (const char*)g.A + (size_t)cur.pm * tstepA; const char* cB = (const char*)g.Bt + (size_t)cur.pn * tstepB;
    if constexpr (SP2) {
        PG8_STAGE(PG8_SB(0, 0), cB + PG8_KOFF(0), voffB); PG8_STAGE(PG8_SB(0, 1), cB + hstepB + PG8_KOFF(0), voffB); PG8_STAGE(PG8_SA(0, 0), cA + PG8_KOFF(0), voffA); PG8_STAGE(PG8_SA(0, 1), cA + hstepA + PG8_KOFF(0), voffA);
        if (wr == 1) PG8_BAR;
        PG8_WAIT_V(2); PG8_BAR;
        PG8_STAGE(PG8_SB(1, 0), cB + PG8_KOFF(1), voffB); PG8_STAGE(PG8_SA(1, 0), cA + PG8_KOFF(1), voffA); PG8_STAGE(PG8_SB(1, 1), cB + hstepB + PG8_KOFF(1), voffB);
        PG8_WAIT_V(6); PG8_BAR;
    } else {
        PG8_STAGE(PG8_SB(0, 0), cB, voffB); PG8_STAGE(PG8_SA(0, 0), cA, voffA); PG8_STAGE(PG8_SB(0, 1), cB + hstepB, voffB); PG8_STAGE(PG8_SA(0, 1), cA + hstepA, voffA);
        if (wr == 1) PG8_BAR;
        PG8_WAIT_V(4); PG8_BAR;
        PG8_STAGE(PG8_SB(1, 0), cB + kstep, voffB); PG8_STAGE(PG8_SA(1, 0), cA + kstep, voffA); PG8_STAGE(PG8_SB(1, 1), cB + hstepB + kstep, voffB);
        PG8_WAIT_V(6); PG8_BAR;
    }
    for (;;) {
        const bool has_next = S.next(ui + 1, nxt);
        const char* nA = has_next ? (const char*)g.A + (size_t)nxt.pm * tstepA : cA; const char* nB = has_next ? (const char*)g.Bt + (size_t)nxt.pn * tstepB : cB;
        for (int t = 0; t < nt; t += 2) {
            const bool last = (t == nt - 2);
            const char* a1 = cA + PG8_KOFF(t + 1);
            const char* a2 = last ? nA + PG8_KOFN(0) : cA + PG8_KOFF(t + 2); const char* b2 = last ? nB + PG8_KOFN(0) : cB + PG8_KOFF(t + 2);
            const char* a3 = last ? nA + PG8_KOFN(1) : cA + PG8_KOFF(t + 3); const char* b3 = last ? nB + PG8_KOFN(1) : cB + PG8_KOFF(t + 3);
            if constexpr (SP2) {
            int t_op = t; asm volatile("" : "+s"(t_op));
            const bool rlx = MK_RELAX_WAIT && (t_op == 0) && (ui > 0);
#define PG8_WAIT_V8X() do { if (rlx) asm volatile("s_waitcnt vmcnt(%0)" :: "n"(8 + Epi::NVM) : "memory"); else PG8_WAIT_V(8); } while (0)
            PG8_LDB(B0, 0, 0); PG8_LDB(B1, 0, 1); PG8_SCHED; PG8_LDA(At, 0, 0); PG8_STAGE(PG8_SA(1, 1), a1 + hstepA, voffA);
            PG8_WAIT_V8X(); PG8_WAIT_L(0); PG8_BAR; PG8_MMA(0, 0, At, B0); PG8_MMA(0, 1, At, B1); PG8_BAR; PG8_SCHED;
            PG8_LDA(At, 0, 1); PG8_STAGE(PG8_SB(0, 0), b2, voffB); PG8_STAGE(PG8_SB(0, 1), b2 + hstepB, voffB); PG8_STAGE(PG8_SA(0, 0), a2, voffA);
            PG8_WAIT_V8X(); PG8_WAIT_L(0); PG8_BAR; PG8_MMA(1, 0, At, B0); PG8_MMA(1, 1, At, B1); PG8_BAR; PG8_SCHED;
#undef PG8_WAIT_V8X
            PG8_LDB(B0, 1, 0); PG8_LDB(B1, 1, 1); PG8_SCHED; PG8_LDA(At, 1, 0); PG8_STAGE(PG8_SA(0, 1), a2 + hstepA, voffA);
            PG8_WAIT_V(8); PG8_WAIT_L(0); PG8_BAR; PG8_MMA(0, 0, At, B0); PG8_MMA(0, 1, At, B1); PG8_BAR; PG8_SCHED;
            PG8_LDA(At, 1, 1); PG8_STAGE(PG8_SB(1, 0), b3, voffB); PG8_STAGE(PG8_SB(1, 1), b3 + hstepB, voffB); PG8_STAGE(PG8_SA(1, 0), a3, voffA);
            PG8_WAIT_V(8); PG8_WAIT_L(0); PG8_BAR; PG8_MMA(1, 0, At, B0); PG8_MMA(1, 1, At, B1); PG8_BAR; PG8_SCHED;
            } else {
            PG8_LDB(B0, 0, 0); PG8_SCHED; PG8_LDA(At, 0, 0); PG8_STAGE(PG8_SA(1, 1), a1 + hstepA, voffA);
            PG8_WAIT_L(8); PG8_BAR; PG8_WAIT_L(0); PG8_MMA(0, 0, At, B0); PG8_BAR; PG8_SCHED;
            PG8_LDB(B1, 0, 1); PG8_STAGE(PG8_SB(0, 0), b2, voffB);
            PG8_BAR; PG8_WAIT_L(0); PG8_MMA(0, 1, At, B1); PG8_BAR;
            PG8_LDA(At, 0, 1); PG8_STAGE(PG8_SA(0, 0), a2, voffA);
            PG8_BAR; PG8_WAIT_L(0); PG8_MMA(1, 0, At, B0); PG8_BAR; PG8_SCHED;
            PG8_STAGE(PG8_SB(0, 1), b2 + hstepB, voffB);
            PG8_WAIT_V(6); PG8_BAR; PG8_MMA(1, 1, At, B1); PG8_BAR;
            PG8_LDB(B0, 1, 0); PG8_SCHED; PG8_LDA(At, 1, 0); PG8_STAGE(PG8_SA(0, 1), a2 + hstepA, voffA);
            PG8_WAIT_L(8); PG8_BAR; PG8_WAIT_L(0); PG8_MMA(0, 0, At, B0); PG8_BAR; PG8_SCHED;
            PG8_LDB(B1, 1, 1); PG8_STAGE(PG8_SB(1, 0), b3, voffB);
            PG8_BAR; PG8_WAIT_L(0); PG8_MMA(0, 1, At, B1); PG8_BAR;
            PG8_LDA(At, 1, 1); PG8_STAGE(PG8_SA(1, 0), a3, voffA);
            PG8_BAR; PG8_WAIT_L(0); PG8_MMA(1, 0, At, B0); PG8_BAR; PG8_SCHED;
            PG8_STAGE(PG8_SB(1, 1), b3 + hstepB, voffB);
            PG8_WAIT_V(6); PG8_BAR; PG8_MMA(1, 1, At, B1); PG8_BAR;
            }
        }
        if constexpr (ALIGN_EPI) { if (wr == 0) PG8_BAR; }
        if constexpr (I8) {
            const bool scaled = g.cs != 1.0f;
#pragma unroll
            for (int a = 0; a < 2; ++a)
#pragma unroll
                for (int b = 0; b < 2; ++b)
#pragma unroll
                    for (int m = 0; m < 4; ++m)
#pragma unroll
                        for (int n = 0; n < 2; ++n)
#pragma unroll
                            for (int q = 0; q < 4; ++q) acc[a][b][m][n][q] = (float)__float_as_int(acc[a][b][m][n][q]);
            if (scaled) {
#pragma unroll
                for (int a = 0; a < 2; ++a)
#pragma unroll
                    for (int b = 0; b < 2; ++b)
#pragma unroll
                        for (int m = 0; m < 4; ++m)
#pragma unroll
                            for (int n = 0; n < 2; ++n) acc[a][b][m][n] = acc[a][b][m][n] * g.cs; } }
        { int l2 = lane_id(); asm volatile("" : "+v"(l2));
          if constexpr (Epi::FUSED) { static_assert(ALIGN_EPI, "fused epilogues contain workgroup barriers: both halves must be aligned"); E.fused(acc, cur, wr, wc, l2 & 15, l2 >> 4, lds + STAGE_BYTES, wid); }
          else E(acc, cur, wr, wc, l2 & 15, l2 >> 4); }
        if (!has_next) break;
#pragma unroll
        for (int a = 0; a < 2; ++a)
#pragma unroll
            for (int b = 0; b < 2; ++b)
#pragma unroll
                for (int m = 0; m < 4; ++m)
#pragma unroll
                    for (int n = 0; n < 2; ++n) acc[a][b][m][n] = (f32x4){0.f, 0.f, 0.f, 0.f};
        cur = nxt; cA = nA; cB = nB; ++ui; rev = MK_KREV && (ui & 1);
        if constexpr (ALIGN_EPI) { if (wr == 1) PG8_BAR; }
    }
    PG8_WAIT_V(0);
    if constexpr (!ALIGN_EPI) { if (wr == 0) PG8_BAR; }
    PG8_BAR;
#undef PG8_SA
#undef PG8_SB
#undef PG8_STAGE
#undef PG8_KOFF
#undef PG8_KOFN
#undef PG8_LDA
#undef PG8_LDB
#undef PG8_MMA
#undef PG8_WAIT_V
#undef PG8_WAIT_L
#undef PG8_BAR
#undef PG8_SCHED
}
}

#define XB_TMO      128
#define XB_XCNT(j)  (256  + 64 * (j))
#define XB_XSUB(j)  (1280 + 64 * (j))
#define XB_XGEN(j)  (2304 + 64 * (j))
#define XB_TOP      3328
#define XB_TOPGEN   3392
#define XCD_BAR_WORDS 3456
#define XB_SPIN_CAP (1u << 18)
__device__ __forceinline__ unsigned xb_ld(unsigned* p)              { return __hip_atomic_load(p, __ATOMIC_RELAXED, __HIP_MEMORY_SCOPE_AGENT); }
__device__ __forceinline__ unsigned xb_add(unsigned* p, unsigned v) { return __hip_atomic_fetch_add(p, v, __ATOMIC_RELAXED, __HIP_MEMORY_SCOPE_AGENT); }
__device__ __forceinline__ unsigned xb_xcc_id() { return (unsigned)__builtin_amdgcn_s_getreg((3 << 11) | 20) & 0xFu; }
#define XB_SPIN(cond, bar) do { unsigned _sp = 0; while (cond) { __builtin_amdgcn_s_sleep(1); \
    if ((++_sp & 255u) == 0u) { if (xb_ld(&(bar)[XB_TMO])) break; if (_sp > XB_SPIN_CAP) { atomicAdd(&(bar)[XB_TMO], 1u); break; } } } } while (0)
struct XcdBarrier { unsigned* bar; unsigned x; volatile LAS unsigned* st; };
__device__ __forceinline__ XcdBarrier xcd_barrier_post(unsigned* bar, volatile LAS unsigned* st, int wv) {
    XcdBarrier b; b.bar = bar; b.x = xb_xcc_id(); b.st = st;
    if (wv == 0 && lane_id() == 0) (void)xb_add(&bar[XB_XCNT(b.x)], 1u);
    return b;
}
__device__ __forceinline__ void xcd_barrier_complete(unsigned* bar, unsigned x, unsigned& nloc, unsigned& nx) {
    const unsigned G = gridDim.x * gridDim.y * gridDim.z;
    unsigned sum, cnt, mine, sp = 0u;
    for (;;) {
        sum = 0u; cnt = 0u; mine = 0u;
#pragma unroll
        for (unsigned j = 0; j < 16; ++j) { const unsigned c = xb_ld(&bar[XB_XCNT(j)]); sum += c; cnt += (c > 0u) ? 1u : 0u; mine = (j == x) ? c : mine; }
        if (sum == G) break;
        __builtin_amdgcn_s_sleep(1);
        if ((++sp & 255u) == 0u) { if (xb_ld(&bar[XB_TMO])) break; if (sp > XB_SPIN_CAP) { atomicAdd(&bar[XB_TMO], 1u); break; } }
    }
    nloc = mine > 0u ? mine : 1u; nx = cnt > 0u ? cnt : 1u;
}
__device__ __forceinline__ void xcd_barrier(const XcdBarrier& b, int wv) {
    asm volatile("s_waitcnt vmcnt(0)" ::: "memory");
    __syncthreads();
    if (wv == 0 && lane_id() == 0) {
        unsigned* bar = b.bar;
        __builtin_amdgcn_s_waitcnt(0);
        unsigned nloc = b.st[0], nx = b.st[1];
        if (nloc == 0u) { xcd_barrier_complete(bar, b.x, nloc, nx); b.st[0] = nloc; b.st[1] = nx; }
        const unsigned old = xb_add(&bar[XB_XSUB(b.x)], 1u);
        const unsigned gen = old / nloc;
        if (old + 1u == (gen + 1u) * nloc) {
            __builtin_amdgcn_fence(__ATOMIC_RELEASE, "agent");
            asm volatile("s_waitcnt vmcnt(0)" ::: "memory");
            const unsigned og = xb_add(&bar[XB_TOP], 1u);
            const unsigned tg = og / nx;
            if (og + 1u == (tg + 1u) * nx) xb_add(&bar[XB_TOPGEN], 1u);
            else XB_SPIN(xb_ld(&bar[XB_TOPGEN]) == tg, bar);
            __builtin_amdgcn_fence(__ATOMIC_ACQUIRE, "agent");
            xb_add(&bar[XB_XGEN(b.x)], 1u);
            asm volatile("s_waitcnt vmcnt(0)" ::: "memory");
        } else {
            XB_SPIN(xb_ld(&bar[XB_XGEN(b.x)]) == gen, bar);
            __builtin_amdgcn_fence(__ATOMIC_ACQUIRE, "agent");
            asm volatile("s_waitcnt vmcnt(0)" ::: "memory");
        }
    }
    __syncthreads();
}

__device__ __forceinline__ void ph_attn_simple(KP p, int vb, int G, int wv) {
    bf16* proj = (bf16*)(p->ws + WS_PROJ);
    const int tid_ = opaque_tid(wv); const int lane = tid_ & 63;
    for (int gw = vb * 8 + (tid_ >> 6); gw < 8192; gw += G * 8) {
        const int qb = gw & 31, h = (gw >> 5) & 15, b = gw >> 9, kvh = h >> 2;
        const size_t row = (size_t)b * SEQ + qb * 64 + lane;
        bf16* qp = proj + row * DIN + O_Q + h * 64;
        float q[64], acc[64];
#pragma unroll
        for (int c = 0; c < 8; ++c) { const u32x4 w = ((const u32x4*)qp)[c]; q[8 * c] = bflo(w.x); q[8 * c + 1] = bfhi(w.x); q[8 * c + 2] = bflo(w.y); q[8 * c + 3] = bfhi(w.y); q[8 * c + 4] = bflo(w.z); q[8 * c + 5] = bfhi(w.z); q[8 * c + 6] = bflo(w.w); q[8 * c + 7] = bfhi(w.w); }
#pragma unroll
        for (int d = 0; d < 64; ++d) acc[d] = 0.f;
        const bf16* kb = proj + (size_t)b * SEQ * DIN + O_K + kvh * 64; const bf16* vbp = proj + (size_t)b * SEQ * DIN + O_V + kvh * 64;
        float m = -1.0e30f, l = 0.f;
        for (int j = 0; j < SEQ; ++j) {
            const u32x4* kr = (const u32x4*)(kb + (size_t)j * DIN); float s = 0.f;
#pragma unroll
            for (int c = 0; c < 8; ++c) { const u32x4 w = kr[c]; s += q[8 * c] * bflo(w.x) + q[8 * c + 1] * bfhi(w.x) + q[8 * c + 2] * bflo(w.y) + q[8 * c + 3] * bfhi(w.y) + q[8 * c + 4] * bflo(w.z) + q[8 * c + 5] * bfhi(w.z) + q[8 * c + 6] * bflo(w.w) + q[8 * c + 7] * bfhi(w.w); }
            const float mn = fmaxf(m, s), a = exp2f(m - mn), pj = exp2f(s - mn); l = l * a + pj; m = mn;
            const u32x4* vr = (const u32x4*)(vbp + (size_t)j * DIN);
#pragma unroll
            for (int c = 0; c < 8; ++c) { const u32x4 w = vr[c];
                acc[8 * c] = acc[8 * c] * a + pj * bflo(w.x); acc[8 * c + 1] = acc[8 * c + 1] * a + pj * bfhi(w.x); acc[8 * c + 2] = acc[8 * c + 2] * a + pj * bflo(w.y); acc[8 * c + 3] = acc[8 * c + 3] * a + pj * bfhi(w.y);
                acc[8 * c + 4] = acc[8 * c + 4] * a + pj * bflo(w.z); acc[8 * c + 5] = acc[8 * c + 5] * a + pj * bfhi(w.z); acc[8 * c + 6] = acc[8 * c + 6] * a + pj * bflo(w.w); acc[8 * c + 7] = acc[8 * c + 7] * a + pj * bfhi(w.w); }
        }
        const float il = 1.0f / l;
#pragma unroll
        for (int c = 0; c < 8; ++c) { u32x4 w; w.x = pk2(acc[8 * c] * il, acc[8 * c + 1] * il); w.y = pk2(acc[8 * c + 2] * il, acc[8 * c + 3] * il); w.z = pk2(acc[8 * c + 4] * il, acc[8 * c + 5] * il); w.w = pk2(acc[8 * c + 6] * il, acc[8 * c + 7] * il); ((u32x4*)qp)[c] = w; }
    }
}
__device__ __forceinline__ void ph_conv_simple(KP p, int layer, LAS unsigned char* lds, int vb, int G, int wv) {
    LAS float* g = (LAS float*)lds; LAS float* pv = g + 4096;
    const int tid = opaque_tid(wv), half = tid >> 8, t0 = tid & 255;
    const bf16* Gf = (const bf16*)(p->ws + WS_GF) + (size_t)layer * 1024 * 2048; const bf16* Gb = (const bf16*)(p->ws + WS_GB) + (size_t)layer * 1024 * 2048;
    bf16* PT = (bf16*)(p->ws + WS_PT);
    for (int u = vb; u < 8192; u += G) {
        const int c = u >> 3, b = (u & 7) * 2 + half;
        __syncthreads();
        for (int i = tid; i < 4096; i += 512) g[i] = i <= 2047 ? bf2f(Gf[(size_t)c * 2048 + 2047 - i]) : (i < 4095 ? bf2f(Gb[(size_t)c * 2048 + i - 2047]) : 0.f);
        bf16* prow = PT + ((size_t)c * NB + b) * SEQ;
        for (int i = t0; i < 2048; i += 256) pv[half * 2048 + i] = bf2f(prow[i]);
        __syncthreads();
        float y[8];
#pragma unroll
        for (int k = 0; k < 8; ++k) y[k] = 0.f;
        for (int s = 0; s < 2048; ++s) { const float pp = pv[half * 2048 + s];
#pragma unroll
            for (int k = 0; k < 8; ++k) y[k] += g[s - (t0 + 256 * k) + 2047] * pp; }
#pragma unroll
        for (int k = 0; k < 8; ++k) prow[t0 + 256 * k] = (bf16)f2bf(y[k]);
    }
}


namespace attn_body {
using bf16=unsigned short;
using bf16x8=__attribute__((ext_vector_type(8)))short;
using s16x4=__attribute__((ext_vector_type(4)))short;
using f32x16=__attribute__((ext_vector_type(16)))float;
using u32x4=__attribute__((ext_vector_type(4)))unsigned;
constexpr int NHEAD=16,NKV=4,SEQ=2048,D=64,DM=8704;
constexpr int NW=8,QBLK=32,QB=QBLK*NW,KVBLK=64,NQB=SEQ/QB;
constexpr int ATTN_PITCH=DM, ATTN_UNIT_ROWS=QB;
__device__ __forceinline__ int crow(int r,int hi){return (r&3)+8*(r>>2)+4*hi;}
#define SBAR() __builtin_amdgcn_sched_barrier(0)
__device__ __forceinline__ void cmask(f32x16&p0,f32x16&p1,int jb,int qrel,int hi){
  const float NEG=-INFINITY; int kb=64*jb+4*hi;
  #pragma unroll
  for(int r=0;r<16;++r){int kv=kb+(r&3)+8*(r>>2); if(kv>qrel)p0[r]=NEG; if(kv+32>qrel)p1[r]=NEG;}
}

constexpr int NSLOT=3, SLOTB=8192;
constexpr int LDS_K=0, LDS_V=NSLOT*SLOTB, LDS_WS=2*NSLOT*SLOTB, LDS_OST=LDS_WS+NW*64*4, LDS_BYTES=LDS_OST+NW*4096;
constexpr float C2=0.125f*1.4426950408889634f;
__device__ __forceinline__ void glds16(const void*gsrc,unsigned lds_dst){unsigned keep;
  asm volatile("s_mov_b32 %0, m0\n\ts_mov_b32 m0, %2\n\ts_nop 0\n\tglobal_load_lds_dwordx4 %1, off\n\ts_mov_b32 m0, %0":"=&s"(keep):"v"(gsrc),"s"(lds_dst):"memory");}
__device__ __forceinline__ float max3f(float a,float b,float c){float r;asm("v_max3_f32 %0, %1, %2, %3":"=v"(r):"v"(a),"v"(b),"v"(c));return r;}
__device__ __forceinline__ float max2f(float a,float b){float r;asm("v_max_f32_e32 %0, %1, %2":"=v"(r):"v"(a),"v"(b));return r;}
__device__ __forceinline__ float fadd_s(float a,float b){float r;asm("v_add_f32_e32 %0, %1, %2":"=v"(r):"v"(a),"v"(b));return r;}
__device__ __forceinline__ float fsub_s(float a,float b){float r;asm("v_sub_f32_e32 %0, %1, %2":"=v"(r):"v"(a),"v"(b));return r;}
typedef float f32x2_t __attribute__((ext_vector_type(2))); typedef __bf16 bf16x2_t __attribute__((ext_vector_type(2)));
__device__ __forceinline__ unsigned cvtpk_s(float lo,float hi){f32x2_t v={lo,hi};bf16x2_t b=__builtin_convertvector(v,bf16x2_t);return __builtin_bit_cast(unsigned,b);}
#define WAIT_BAR(N) asm volatile("s_waitcnt vmcnt(" #N ") lgkmcnt(0)\n\ts_barrier":::"memory")

__device__ __forceinline__ void qkt(f32x16&p0,f32x16&p1,const char*Kslot,const bf16x8*qr,const f32x16&negm,int r32,int hi){
  const char*kb=Kslot+hi*1024+r32*16;
  #pragma unroll
  for(int d0=0;d0<4;++d0){
    const bf16x8 b0=*reinterpret_cast<const bf16x8*>(kb+d0*2048);
    const bf16x8 b1=*reinterpret_cast<const bf16x8*>(kb+d0*2048+512);
    if(d0==0){p0=__builtin_amdgcn_mfma_f32_32x32x16_bf16(b0,qr[0],negm,0,0,0);p1=__builtin_amdgcn_mfma_f32_32x32x16_bf16(b1,qr[0],negm,0,0,0);}
    else{p0=__builtin_amdgcn_mfma_f32_32x32x16_bf16(b0,qr[d0],p0,0,0,0);p1=__builtin_amdgcn_mfma_f32_32x32x16_bf16(b1,qr[d0],p1,0,0,0);}}
}
typedef __attribute__((address_space(3))) const char* lds_cptr;
typedef short v4i16_t __attribute__((ext_vector_type(4)));
__device__ __forceinline__ void kload8(bf16x8*kf,lds_cptr kp){
  kf[0]=*(const __attribute__((address_space(3))) bf16x8*)(kp);      kf[1]=*(const __attribute__((address_space(3))) bf16x8*)(kp+512);
  kf[2]=*(const __attribute__((address_space(3))) bf16x8*)(kp+2048); kf[3]=*(const __attribute__((address_space(3))) bf16x8*)(kp+2560);
  kf[4]=*(const __attribute__((address_space(3))) bf16x8*)(kp+4096); kf[5]=*(const __attribute__((address_space(3))) bf16x8*)(kp+4608);
  kf[6]=*(const __attribute__((address_space(3))) bf16x8*)(kp+6144); kf[7]=*(const __attribute__((address_space(3))) bf16x8*)(kp+6656);
}
__device__ __forceinline__ void kload2(bf16x8*kf,lds_cptr kp,int j){ kf[2*j]=*(const __attribute__((address_space(3))) bf16x8*)(kp+j*2048); kf[2*j+1]=*(const __attribute__((address_space(3))) bf16x8*)(kp+j*2048+512); }
__device__ __forceinline__ s16x4 vtr(lds_cptr p){ return __builtin_bit_cast(s16x4,__builtin_amdgcn_ds_read_tr16_b64_v4i16((__attribute__((address_space(3))) v4i16_t*)p)); }
__device__ __forceinline__ float rowmax(const f32x16&p0,const f32x16&p1){
  float a=max3f(p0[0],p0[1],p1[0]),b=max3f(p0[2],p0[3],p1[1]);a=max3f(a,p1[2],p1[3]);
  #pragma unroll
  for(int r=4;r<16;r+=4){a=max3f(a,p0[r],p0[r+1]);b=max3f(b,p0[r+2],p0[r+3]);a=max3f(a,p1[r],p1[r+1]);b=max3f(b,p1[r+2],p1[r+3]);}
  const float m=max2f(a,b);
  auto rr=__builtin_amdgcn_permlane32_swap(__float_as_uint(m),__float_as_uint(m),false,false);
  return max2f(__uint_as_float(rr[0]),__uint_as_float(rr[1]));
}
__device__ __forceinline__ void pv(f32x16*o,int vb,bf16x8 pa0,bf16x8 pa1,bf16x8 pa2,bf16x8 pa3){
  #pragma unroll
  for(int d0=0;d0<2;++d0){s16x4 lo[4],hi[4];
    #pragma unroll
    for(int ks=0;ks<4;++ks){
      asm volatile("ds_read_b64_tr_b16 %0,%1 offset:%c2":"=&v"(lo[ks]):"v"(vb),"i"(d0*4096+ks*1024):"memory");
      asm volatile("ds_read_b64_tr_b16 %0,%1 offset:%c2":"=&v"(hi[ks]):"v"(vb),"i"(d0*4096+ks*1024+512):"memory");}
    asm volatile("s_waitcnt lgkmcnt(0)":::"memory");SBAR();
    #define PK(k) (bf16x8){lo[k][0],lo[k][1],lo[k][2],lo[k][3],hi[k][0],hi[k][1],hi[k][2],hi[k][3]}
    o[d0]=__builtin_amdgcn_mfma_f32_32x32x16_bf16(pa0,PK(0),o[d0],0,0,0);
    o[d0]=__builtin_amdgcn_mfma_f32_32x32x16_bf16(pa1,PK(1),o[d0],0,0,0);
    o[d0]=__builtin_amdgcn_mfma_f32_32x32x16_bf16(pa2,PK(2),o[d0],0,0,0);
    o[d0]=__builtin_amdgcn_mfma_f32_32x32x16_bf16(pa3,PK(3),o[d0],0,0,0);
    #undef PK
  }
}

#ifndef ATTN_STORE16
#define ATTN_STORE16(p,v) (*(u32x4*)(p)=(v))
#endif
template<int THRL> __device__ __forceinline__ void attn_unit(int b,int h,int qb,const bf16*Q,const bf16*K,const bf16*V,bf16*O,char*shm,int wv){
  const int tid=opaque_tid(wv),lane=tid&63,r32=lane&31,hi=lane>>5; const int wid=__builtin_amdgcn_readfirstlane(tid>>6);
  const long rowbase=(long)b*SEQ; const int q0=qb*QB;
  const bf16*Qw=Q+(rowbase+q0+wid*QBLK)*DM;
  const bf16*Kh=K+rowbase*DM,*Vh=V+rowbase*DM; (void)h;
  const unsigned lds0=(unsigned)(uintptr_t)shm;
  float*wsf=(float*)(shm+LDS_WS)+wid*64;
  const bf16*ksrc=Kh+(long)lane*DM+wid*8;
  const bf16*vsrc=Vh+(long)(16*(wid&3)+(lane>>2))*DM+(wid>>2)*32+(lane&3)*8;
  const unsigned kdst=lds0+LDS_K+wid*1024, vdst=lds0+LDS_V+wid*1024;
  #define DMA_K(t,slot) glds16(ksrc+(long)(t)*KVBLK*DM,(unsigned)__builtin_amdgcn_readfirstlane(kdst+(slot)))
  #define DMA_V(t,slot) glds16(vsrc+(long)(t)*KVBLK*DM,(unsigned)__builtin_amdgcn_readfirstlane(vdst+(slot)))
  const int vb0=(int)(lds0+LDS_V)+((lane>>4)&1)*32+(lane&3)*8+(4*hi+((lane&15)>>2))*64;
  const char*Kbase=shm+LDS_K; bf16x8 kf[8];
  const lds_cptr shm3=(lds_cptr)shm; const lds_cptr kp0=shm3+LDS_K+hi*1024+r32*16; const lds_cptr vp0=shm3+LDS_V+((lane>>4)&1)*32+(lane&3)*8+(4*hi+((lane&15)>>2))*64;
  constexpr int NT=SEQ/KVBLK;
  DMA_K(0,0);DMA_V(0,0);DMA_K(1,SLOTB);
  bf16x8 qr[4];
  #pragma unroll
  for(int d0=0;d0<4;++d0)qr[d0]=*reinterpret_cast<const bf16x8*>(&Qw[(long)r32*DM+d0*16+hi*8]);
  float mhat=0.f,l_reg=0.f;f32x16 o[2];o[0]=f32x16{};o[1]=f32x16{};f32x16 negm=f32x16{};asm volatile("":"+v"(negm));
  #define CMASK(P0,P1,t) do{}while(0)
  bool resc=false;
  #define START(P0,P1) do{ const float rm=rowmax(P0,P1); resc=false; \
    { const float dl=rm; mhat=fadd_s(mhat,dl); \
      _Pragma("unroll") for(int r=0;r<16;++r){P0[r]=fsub_s(P0[r],dl);P1[r]=fsub_s(P1[r],dl);} \
      _Pragma("unroll") for(int r=0;r<16;++r)negm[r]=-mhat; asm volatile("":"+v"(negm)); } \
    _Pragma("unroll") for(int r=0;r<16;++r)P0[r]=__builtin_amdgcn_exp2f(P0[r]); }while(0)
  #define RESC() do{ if(resc){ asm volatile("s_waitcnt lgkmcnt(0)":::"memory"); \
      _Pragma("unroll") for(int d_=0;d_<2;++d_) _Pragma("unroll") for(int r=0;r<16;++r)o[d_][r]*=wsf[crow(r,hi)]; } }while(0)
  f32x16 pA0,pA1,pB0,pB1;
  int sl_prev=0,sl_cur=0,sl_next=SLOTB;
  #define ROT() do{sl_prev=sl_cur;sl_cur=sl_next;sl_next=(sl_next==(NSLOT-1)*SLOTB)?0:sl_next+SLOTB;}while(0)
  DMA_K(2,2*SLOTB);
  WAIT_BAR(3);
  qkt(pA0,pA1,Kbase,qr,negm,r32,hi);asm volatile("s_nop 15\n\ts_nop 7":"+v"(pA0),"+v"(pA1));CMASK(pA0,pA1,0);
  START(pA0,pA1);
  _Pragma("unroll") for(int r=0;r<16;++r)pA1[r]=__builtin_amdgcn_exp2f(pA1[r]);
  WAIT_BAR(0);
  DMA_K(3,0);DMA_V(1,SLOTB);
  ROT();
  kload8(kf,kp0+sl_cur);
  WAIT_BAR(2);
  s16x4 vlo[8],vhi[8]; u32x4 pw0,pw1,pw2,pw3;
  #define PKW(P,B) cvtpk_s(P[B],P[B+1])
  #define PAF(k) __builtin_bit_cast(bf16x8,pw##k)
  #define VFR(i) (bf16x8){vlo[i][0],vlo[i][1],vlo[i][2],vlo[i][3],vhi[i][0],vhi[i][1],vhi[i][2],vhi[i][3]}
  #define PIN(x) asm volatile("":"+v"(x))
  #define MX3(a,b,c) __builtin_fmaxf(__builtin_fmaxf((a),(b)),(c))
  #define GAPA(MF,A0,A1,A2,A3,W0,W1,PW) do{ MF; sacc+=A0; sacc+=A1; sacc+=A2; sacc+=A3; PIN(sacc); W0; W1; PIN(PW); SBAR(); }while(0)
  #define EX(v) __builtin_amdgcn_exp2f(v)
  #define GAPB(MF,X,B) do{ MF; X[B]=EX(X[B]); X[B+1]=EX(X[B+1]); X[B+2]=EX(X[B+2]); X[B+3]=EX(X[B+3]); PIN(X); SBAR(); }while(0)
  #define VRD(i) do{ vlo[i]=vtr(vp_+(((i)>>2)*4096+((i)&3)*1024)); vhi[i]=vtr(vp_+(((i)>>2)*4096+((i)&3)*1024+512)); }while(0)
  #define KRD(G,j) do{ if(G){ kload2(kf,kp0+sl_next,j); SBAR(); } }while(0)
  #define STEP(C0,C1,P0,P1,t,GK,GV,GL) do{ SBAR(); \
    const lds_cptr vp_=vp0+sl_prev; \
    VRD(0); SBAR(); float sacc=(P0[0]+P0[1]); \
    GAPA(C0=__builtin_amdgcn_mfma_f32_32x32x16_bf16(kf[0],qr[0],negm,0,0,0), P0[2],P0[3],P0[4],P0[5],     pw0[0]=PKW(P0,0), pw0[1]=PKW(P0,2), pw0); \
    VRD(4); SBAR(); GAPA(C1=__builtin_amdgcn_mfma_f32_32x32x16_bf16(kf[1],qr[0],negm,0,0,0), P0[6],P0[7],P0[8],P0[9],     pw0[2]=PKW(P0,4), pw0[3]=PKW(P0,6), pw0); \
    VRD(1); SBAR(); GAPA(C0=__builtin_amdgcn_mfma_f32_32x32x16_bf16(kf[2],qr[1],C0,0,0,0),   P0[10],P0[11],P0[12],P0[13], pw1[0]=PKW(P0,8), pw1[1]=PKW(P0,10), pw1); \
    VRD(5); SBAR(); GAPA(C1=__builtin_amdgcn_mfma_f32_32x32x16_bf16(kf[3],qr[1],C1,0,0,0),   P0[14],P0[15],P1[0],P1[1],   pw1[2]=PKW(P0,12),pw1[3]=PKW(P0,14), pw1); \
    VRD(2); SBAR(); GAPA(C0=__builtin_amdgcn_mfma_f32_32x32x16_bf16(kf[4],qr[2],C0,0,0,0),   P1[2],P1[3],P1[4],P1[5],     pw2[0]=PKW(P1,0), pw2[1]=PKW(P1,2), pw2); \
    VRD(6); SBAR(); GAPA(C1=__builtin_amdgcn_mfma_f32_32x32x16_bf16(kf[5],qr[2],C1,0,0,0),   P1[6],P1[7],P1[8],P1[9],     pw2[2]=PKW(P1,4), pw2[3]=PKW(P1,6), pw2); \
    VRD(3); SBAR(); GAPA(C0=__builtin_amdgcn_mfma_f32_32x32x16_bf16(kf[6],qr[3],C0,0,0,0),   P1[10],P1[11],P1[12],P1[13], pw3[0]=PKW(P1,8), pw3[1]=PKW(P1,10), pw3); \
    VRD(7); SBAR(); GAPA(C1=__builtin_amdgcn_mfma_f32_32x32x16_bf16(kf[7],qr[3],C1,0,0,0),   P1[14],P1[15],0.f,0.f,       pw3[2]=PKW(P1,12),pw3[3]=PKW(P1,14), pw3); \
    l_reg+=sacc; \
    if(GK){DMA_K((t)+3,sl_cur);} if(GV){DMA_V((t)+1,sl_next);} \
    CMASK(C0,C1,t); \
    { float a=MX3(C0[0],C0[1],C1[0]),b=MX3(C0[2],C0[3],C1[1]); a=MX3(a,C1[2],C1[3]); \
      _Pragma("unroll") for(int r=4;r<16;r+=4){a=MX3(a,C0[r],C0[r+1]);b=MX3(b,C0[r+2],C0[r+3]);a=MX3(a,C1[r],C1[r+1]);b=MX3(b,C1[r+2],C1[r+3]);} \
      float rm=__builtin_fmaxf(a,b); { auto rr=__builtin_amdgcn_permlane32_swap(__float_as_uint(rm),__float_as_uint(rm),false,false); rm=__builtin_fmaxf(__uint_as_float(rr[0]),__uint_as_float(rr[1])); } \
      resc=false; \
      if(__builtin_expect(__any(rm>(float)THRL),0)){ const float dl=__builtin_fmaxf(rm,0.f); mhat+=dl; \
        _Pragma("unroll") for(int r=0;r<16;++r){C0[r]-=dl;C1[r]-=dl;} \
        _Pragma("unroll") for(int r=0;r<16;++r)negm[r]=-mhat; asm volatile("":"+v"(negm)); \
        const float f=__builtin_amdgcn_exp2f(-dl); l_reg*=f; if(hi==0)wsf[r32]=f; resc=true; } } \
    SBAR(); \
    GAPB(o[0]=__builtin_amdgcn_mfma_f32_32x32x16_bf16(PAF(0),VFR(0),o[0],0,0,0), C0,0); \
    GAPB(o[1]=__builtin_amdgcn_mfma_f32_32x32x16_bf16(PAF(0),VFR(4),o[1],0,0,0), C0,4); \
    KRD(GL,0); GAPB(o[0]=__builtin_amdgcn_mfma_f32_32x32x16_bf16(PAF(1),VFR(1),o[0],0,0,0), C0,8); \
    KRD(GL,1); GAPB(o[1]=__builtin_amdgcn_mfma_f32_32x32x16_bf16(PAF(1),VFR(5),o[1],0,0,0), C0,12); \
    KRD(GL,2); GAPB(o[0]=__builtin_amdgcn_mfma_f32_32x32x16_bf16(PAF(2),VFR(2),o[0],0,0,0), C1,0); \
    KRD(GL,3); GAPB(o[1]=__builtin_amdgcn_mfma_f32_32x32x16_bf16(PAF(2),VFR(6),o[1],0,0,0), C1,4); \
    GAPB(o[0]=__builtin_amdgcn_mfma_f32_32x32x16_bf16(PAF(3),VFR(3),o[0],0,0,0), C1,8); \
    GAPB(o[1]=__builtin_amdgcn_mfma_f32_32x32x16_bf16(PAF(3),VFR(7),o[1],0,0,0), C1,12); \
    }while(0)
  int t=1;
  #undef CMASK
  #define CMASK(P0,P1,t) do{}while(0)
  for(;t+5<NT;t+=2){
    STEP(pB0,pB1,pA0,pA1,t,true,true,true);     WAIT_BAR(2); RESC(); ROT();
    STEP(pA0,pA1,pB0,pB1,t+1,true,true,true);   WAIT_BAR(2); RESC(); ROT();
  }
  #undef CMASK
  #define CMASK(P0,P1,t) do{}while(0)
  #define ENDW(tt) do{ if((tt)+3<NT){WAIT_BAR(2);} else if((tt)+2<NT){WAIT_BAR(1);} else {WAIT_BAR(0);} }while(0)
  for(;t+1<NT;t+=2){
    STEP(pB0,pB1,pA0,pA1,t,(t+3<NT),(t+1<NT),(t+1<NT));       ENDW(t);   RESC(); ROT();
    STEP(pA0,pA1,pB0,pB1,t+1,(t+4<NT),(t+2<NT),(t+2<NT));     ENDW(t+1); RESC(); ROT();
  }
  STEP(pB0,pB1,pA0,pA1,NT-1,false,false,false); RESC();
  { float sacc=pB0[0]+pB0[1]; _Pragma("unroll") for(int r=2;r<16;++r)sacc+=pB0[r]; _Pragma("unroll") for(int r=0;r<16;++r)sacc+=pB1[r]; l_reg+=sacc;
    pw0=(u32x4){PKW(pB0,0),PKW(pB0,2),PKW(pB0,4),PKW(pB0,6)};pw1=(u32x4){PKW(pB0,8),PKW(pB0,10),PKW(pB0,12),PKW(pB0,14)};pw2=(u32x4){PKW(pB1,0),PKW(pB1,2),PKW(pB1,4),PKW(pB1,6)};pw3=(u32x4){PKW(pB1,8),PKW(pB1,10),PKW(pB1,12),PKW(pB1,14)};
    SBAR(); pv(o,vb0+sl_cur,PAF(0),PAF(1),PAF(2),PAF(3)); }
  #undef PKW
  #undef PAF
  #undef VFR
  #undef PIN
  #undef MX3
  #undef GAPA
  #undef GAPB
  #undef EX
  #undef VRD
  #undef KRD
  #undef STEP
  #undef ENDW
  {auto rr=__builtin_amdgcn_permlane32_swap(__float_as_uint(l_reg),__float_as_uint(l_reg),false,false);l_reg=__uint_as_float(rr[0])+__uint_as_float(rr[1]);}
  if(hi==0)wsf[32+r32]=l_reg;asm volatile("s_waitcnt lgkmcnt(0)":::"memory");
  float rli[16];
  #pragma unroll
  for(int r=0;r<16;++r)rli[r]=__builtin_amdgcn_rcpf(wsf[32+crow(r,hi)]);
  bf16*Ow=O+(rowbase+q0+wid*QBLK)*DM;
  { bf16*stg=(bf16*)(shm+LDS_OST)+wid*2048;
    #pragma unroll
    for(int r=0;r<16;++r){const int orow=crow(r,hi);
      #pragma unroll
      for(int d0=0;d0<2;++d0)stg[orow*64+d0*32+r32]=(bf16)f2bf(o[d0][r]*rli[r]);}
    asm volatile("s_waitcnt lgkmcnt(0)":::"memory");
    #pragma unroll
    for(int i=0;i<4;++i){const int row=i*8+(lane>>3),ch=lane&7; const u32x4 v=*(const u32x4*)(stg+row*64+ch*8); ATTN_STORE16(Ow+(long)row*DM+ch*8,v);} }
  asm volatile("s_waitcnt lgkmcnt(0)\n\ts_barrier":::"memory");
  #undef DMA_K
  #undef DMA_V
  #undef CMASK
  #undef START
  #undef RESC
  #undef ROT
}
constexpr int ATTN_LDS_BYTES=LDS_BYTES;
#undef SBAR
#undef WAIT_BAR
}

__device__ __forceinline__ void ph_attn(KP p, char* lds_generic, int vcu, int G, int wv) {
    bf16* proj = (bf16*)(p->ws + WS_PROJ);
    for (int bh = vcu; bh < NB * 16; bh += G) { const int b = bh >> 4, h = bh & 15, kvh = h >> 2;
        for (int qb = 0; qb < SEQ / 256; ++qb)
            attn_body::attn_unit<8>(b, h, qb, proj + O_Q + h * 64, proj + O_K + kvh * 64, proj + O_V + kvh * 64, proj + O_Q + h * 64, lds_generic, wv); }
}

namespace hyconv {
constexpr int CB = 8256, PROW = 4112, OFF_P = 8 * CB, OFF_T = OFF_P + 16 * PROW, LDS_END = OFF_T + 8208;
static_assert(LDS_END <= 147200, "conv LDS");
__device__ __forceinline__ void ph_conv(KP p, int layer, LAS unsigned char* lds, int vb, int G, int wv) {
    const int tid = opaque_tid(wv), lane = tid & 63, wid = tid >> 6, fr = lane & 15, fq = lane >> 4;
    const bf16* Gf = (const bf16*)(p->ws + WS_GF) + (size_t)layer * 1024 * 2048; const bf16* Gb = (const bf16*)(p->ws + WS_GB) + (size_t)layer * 1024 * 2048;
    bf16* PT = (bf16*)(p->ws + WS_PT);
    const int tw = 256 * wid;
    const LAS unsigned char* tb = lds + (7 - (fr & 7)) * CB + (255 - (fr >> 3) + fq) * 16 - 2 * tw;
    const LAS unsigned char* pb = lds + OFF_P + fr * PROW + fq * 16;
    for (int c = vb; c < 1024; c += G) {
        __syncthreads();
        LAS bf16* tmp = (LAS bf16*)(lds + OFF_T);
        for (int i = tid; i < 4104; i += 512) { bf16 v = 0; if (i <= 2047) v = Gf[(size_t)c * 2048 + 2047 - i]; else if (i <= 4094) v = Gb[(size_t)c * 2048 + i - 2047]; tmp[i] = v; }
        { const u32x4* src = (const u32x4*)(PT + (size_t)c * NB * SEQ);
#pragma unroll
          for (int k = 0; k < 8; ++k) { const int q = tid + 512 * k; *(LAS u32x4*)(lds + OFF_P + (q >> 8) * PROW + (q & 255) * 16) = src[q]; } }
        __syncthreads();
        {
          const u32x4 lo = *(const LAS u32x4*)(lds + OFF_T + tid * 16), hi = *(const LAS u32x4*)(lds + OFF_T + tid * 16 + 16);
          const unsigned W[8] = {lo.x, lo.y, lo.z, lo.w, hi.x, hi.y, hi.z, hi.w};
#pragma unroll
          for (int k = 0; k < 8; ++k) { u32x4 o;
              if ((k & 1) == 0) { o.x = W[k / 2]; o.y = W[k / 2 + 1]; o.z = W[k / 2 + 2]; o.w = W[k / 2 + 3]; }
              else { const int b = (k - 1) / 2; o.x = (W[b] >> 16) | (W[b + 1] << 16); o.y = (W[b + 1] >> 16) | (W[b + 2] << 16); o.z = (W[b + 2] >> 16) | (W[b + 3] << 16); o.w = (W[b + 3] >> 16) | (W[b + 4] << 16); }
              *(LAS u32x4*)(lds + k * CB + tid * 16) = o; } }
        __syncthreads();
        f32x4 acc[16]; bf16x8 Wn[16];
#pragma unroll
        for (int i = 0; i < 16; ++i) { acc[i] = (f32x4){0.f, 0.f, 0.f, 0.f}; Wn[i] = *(const LAS bf16x8*)(tb - 32 * i); }
        bf16x8 pf = *(const LAS bf16x8*)pb;
        for (int j8 = 0; j8 < 8; ++j8) {
#pragma unroll
            for (int jj = 0; jj < 8; ++jj) {
                const int j = 8 * j8 + jj;
                const bf16x8 pcur = pf;
                if (j + 1 < 64) pf = *(const LAS bf16x8*)(pb + 64 * (j + 1));
#pragma unroll
                for (int i = 15; i >= 0; --i) {
                    acc[i] = __builtin_amdgcn_mfma_f32_16x16x32_bf16(Wn[(i - 2 * jj) & 15], pcur, acc[i], 0, 0, 0);
                    if (i == 14 && j + 1 < 64) {
                        Wn[(16 - 2 * (jj + 1)) & 15] = *(const LAS bf16x8*)(tb + 64 * (j + 1));
                        Wn[(17 - 2 * (jj + 1)) & 15] = *(const LAS bf16x8*)(tb + 64 * (j + 1) - 32); }
                }
            }
        }
        bf16* orow = PT + ((size_t)c * NB + fr) * SEQ + tw + 4 * fq;
#pragma unroll
        for (int i = 0; i < 16; ++i) { u32x2 w; w.x = pk2(acc[i][0], acc[i][1]); w.y = pk2(acc[i][2], acc[i][3]); *(u32x2*)(orow + 16 * i) = w; }
    }
}
}
#ifndef MK_ATTN_SIMPLE
#define MK_ATTN_SIMPLE 0
#endif
#ifndef MK_CONV_SIMPLE
#define MK_CONV_SIMPLE 0
#endif
constexpr int LDS_BYTES = 147456;
constexpr int MISC_OFF = 147200;
constexpr int CW_BAR = 4096;
constexpr int N_PHASES = 41;
#ifndef MK_GEMM_SP2
#define MK_GEMM_SP2 true
#endif
#ifndef MK_GEMM_ALIGN
#define MK_GEMM_ALIGN true
#endif

__global__ void __launch_bounds__(512, 2) k_mega(Params p_arg) {
    extern __shared__ __attribute__((aligned(16))) unsigned char lds_raw[];
    LAS unsigned char* lds = (LAS unsigned char*)lds_raw;
    (void)p_arg;
#define KARGS() ({ KP _k = (KP)__builtin_amdgcn_kernarg_segment_ptr(); asm volatile("" : "+s"(_k)); _k; })
    const int G = gridDim.x, vb = blockIdx.x;
    const int wv = __builtin_amdgcn_readfirstlane((int)threadIdx.x >> 6);
    volatile LAS unsigned* MISC = (volatile LAS unsigned*)(lds + MISC_OFF);
    if (wv == 0 && lane_id() < 32) MISC[lane_id()] = 0u;
    __syncthreads();
    int lo, hi; XcdBarrier bar;
    { KP p = KARGS(); lo = p->ph_lo; hi = p->ph_hi; bar = xcd_barrier_post((unsigned*)(p->ws + WS_CTL) + CW_BAR, MISC + 8, wv); }
#define IN(k) (lo <= (k) && (k) < hi)
#define SEAM(k) do { if (lo <= (k) && (k) + 1 < hi) xcd_barrier(bar, wv); } while (0)
#define WSP(T, off) ((T*)(ws + (off)))

#if MK_DENSE_I8 || MK_I8_GATES || MK_I8_MOE
    if (IN(0)) { { KP p = KARGS(); ph_wstats(p, vb, G, wv); } xcd_barrier(bar, wv); }
#endif
    if (IN(0)) { KP p = KARGS(); ph_transpose(p, lds, vb, G, wv); ph_ln_in(p, vb, G, wv); ph_rope(p, vb, G, wv); ph_filter(p, lds, vb, G, wv); }
    SEAM(0);
    for (int l = 0; l < 2; ++l) {
        const int base = 1 + 20 * l;
        if (IN(base + 0)) {
            if ((MK_I8_PROJ >> l) & 1) {
              { KP p = KARGS(); unsigned char* ws = p->ws;
                pg8::Gemm g{ws + WS_HF8, ws + WS_WIN8 + (size_t)l * DIN * DM, DM, DM, (i8_range_a(p, l ? 2 : 0) * (1.0f / 127.0f)) * (i8_range_w(p, 1) * (1.0f / 127.0f))};
                pg8::StaticOrder S{NT / 256, MK_I8_QKV_BF16 == 1 ? DIN / 256 - 6 : (MK_I8_QKV_BF16 == 2 ? DIN / 256 - 12 : DIN / 256), G, vb, 0, MK_I8_QKV_BF16 == 1 ? 12 : (MK_I8_QKV_BF16 == 2 ? 0 : (1 << 30)), MK_I8_QKV_BF16 == 1 ? 6 : (MK_I8_QKV_BF16 == 2 ? 12 : 0)};
                pg8::EpiProj E{WSP(bf16, WS_PROJ), DIN, p->in[13] + l * 64, p->in[14] + l * 64, WSP(float, WS_ROPE), WSP(float, WS_ROPE) + SEQ * 32};
                pg8::gemm_phase<pg8::EpiProj, pg8::StaticOrder, MK_GEMM_ALIGN, MK_GEMM_SP2, 1, true>(lds, g, S, E, wv); }
#if MK_I8_QKV_BF16
              asm volatile("s_waitcnt vmcnt(0)" ::: "memory"); __syncthreads();
              { KP p = KARGS(); unsigned char* ws = p->ws;
                constexpr int NB16 = MK_I8_QKV_BF16 == 1 ? O_G - O_Q : O_Q; pg8::Gemm g{WSP(bf16, WS_H0), WSP(bf16, WS_WIN) + (size_t)l * NB16 * DM, DM, DM}; pg8::StaticOrder S{NT / 256, NB16 / 256, G, vb, MK_I8_QKV_BF16 == 1 ? 12 : 0};
                pg8::EpiProj E{WSP(bf16, WS_PROJ), DIN, p->in[13] + l * 64, p->in[14] + l * 64, WSP(float, WS_ROPE), WSP(float, WS_ROPE) + SEQ * 32};
                pg8::gemm_phase<pg8::EpiProj, pg8::StaticOrder, MK_GEMM_ALIGN, MK_GEMM_SP2>(lds, g, S, E, wv); }
#endif
            } else {
            KP p = KARGS(); unsigned char* ws = p->ws;
            { pg8::Gemm g{WSP(bf16, WS_H0), WSP(bf16, WS_WIN) + (size_t)l * NPB * DM, DM, DM}; pg8::StaticOrder S{NT / 256, NPB / 256, G, vb};
#if MK_QK_EPI
              pg8::EpiProj E{WSP(bf16, WS_PROJ), DIN, p->in[13] + l * 64, p->in[14] + l * 64, WSP(float, WS_ROPE), WSP(float, WS_ROPE) + SEQ * 32};
              pg8::gemm_phase<pg8::EpiProj, pg8::StaticOrder, MK_GEMM_ALIGN, MK_GEMM_SP2>(lds, g, S, E, wv); }
#else
              pg8::EpiStore E{WSP(bf16, WS_PROJ), DIN};
              pg8::gemm_phase<pg8::EpiStore, pg8::StaticOrder, MK_GEMM_ALIGN, MK_GEMM_SP2>(lds, g, S, E, wv); }
#endif
            asm volatile("s_waitcnt vmcnt(0)" ::: "memory"); __syncthreads();
            {
              KP p2 = KARGS(); unsigned char* ws2 = p2->ws;
              pg8::Gemm g{ws2 + WS_HF8, ws2 + WS_WING + (size_t)l * 4096 * DM, DM, DM}; pg8::StaticOrder S{NT / 256, 4096 / 256, G, vb}; pg8::EpiStoreScaled E{(bf16*)(ws2 + WS_PROJ) + O_G, DIN, MK_I8_GATES ? (i8_range_a(p2, l ? 2 : 0) * (1.0f / 127.0f)) * (i8_range_w(p2, 1) * (1.0f / 127.0f)) : 1.0f / SC_GU};
              pg8::gemm_phase<pg8::EpiStoreScaled, pg8::StaticOrder, MK_GEMM_ALIGN, MK_GEMM_SP2, 1, MK_I8_GATES != 0>(lds, g, S, E, wv); }
            }
        }
        SEAM(base + 0);
        if (IN(base + 1)) { KP p = KARGS(); if (!MK_QK_EPI) ph_qk_prep(p, l, vb, G, wv); ph_hy_prep(p, l, lds, vb, G, wv); }
        SEAM(base + 1);
        if (IN(base + 2)) { KP p = KARGS(); const int vcu = (G % 8 == 0) ? (vb % 8) * (G / 8) + vb / 8 : vb;
#if MK_ATTN_SIMPLE
            ph_attn_simple(p, vb, G, wv);
#else
            ph_attn(p, (char*)lds_raw, vcu, G, wv); __syncthreads();
#endif
#if MK_CONV_SIMPLE
            ph_conv_simple(p, l, lds, vb, G, wv);
#else
            hyconv::ph_conv(p, l, lds, vb, G, wv);
#endif
        }
        SEAM(base + 2);
        if (IN(base + 3)) { KP p = KARGS(); if (MK_BR1_I8 && MK_WO_I8) ph_hy_post_q(p, l, lds, vb, G, wv); else ph_hy_post(p, l, lds, vb, G, wv); }
        SEAM(base + 3);
        if (IN(base + 4)) {
#if MK_WO_I8
            static_assert(MK_I8_PROJ == 3 && MK_I8_QKV_BF16 == 0, "the int8 merged buffer lives in the WIN / WING slots");
            { KP p = KARGS(); unsigned char* ws = p->ws; bf16* PROJ = WSP(bf16, WS_PROJ);
#if MK_BR1_I8
              pg8::Gemm g{ws + WS_YHY, ws + WS_WHB + (size_t)l * DM * DH, DH, DH, i8_range_w(p, 4) * (1.0f / 127.0f)}; pg8::PanelOrder S{NT / 256, G, vb};
              pg8::EpiGate<false> E{PROJ + O_G, DIN, PROJ, DIN, nullptr, WSP(float, WS_XBUF + 15 * MiB)};
              pg8::gemm_phase<pg8::EpiGate<false>, pg8::PanelOrder, true, MK_GEMM_SP2, 1, true>(lds, g, S, E, wv); }
#else
              pg8::Gemm g{WSP(bf16, WS_YHY), WSP(bf16, WS_WHB) + (size_t)l * DM * DH, DH, DH}; pg8::PanelOrder S{NT / 256, G, vb}; pg8::EpiGate<false> E{PROJ + O_G, DIN, PROJ, DIN};
              pg8::gemm_phase<pg8::EpiGate<false>, pg8::PanelOrder, true, MK_GEMM_SP2>(lds, g, S, E, wv); }
#endif
            asm volatile("s_waitcnt vmcnt(0)" ::: "memory"); __syncthreads();
            { KP p = KARGS(); unsigned char* ws = p->ws; bf16* PROJ = WSP(bf16, WS_PROJ);
              pg8::Gemm g{PROJ + O_Q, WSP(bf16, WS_WAB) + (size_t)l * DM * DA, DIN, DA}; pg8::PanelOrder S{NT / 256, G, vb};
              pg8::EpiGateQ E{PROJ + O_G + DM, DIN, PROJ, DIN, ws + WS_M8, WSP(float, WS_XBUF + 12 * MiB), WSP(unsigned, WS_XBUF + 8 * MiB) + (size_t)l * NT * 8, WSP(unsigned, WS_CTL) + CW_PANEL + (4 + l) * 8192, WSP(unsigned, WS_CTL) + CW_TMO};
              pg8::gemm_phase<pg8::EpiGateQ, pg8::PanelOrder, true, MK_GEMM_SP2>(lds, g, S, E, wv); }
#else
            { KP p = KARGS(); unsigned char* ws = p->ws; bf16* PROJ = WSP(bf16, WS_PROJ);
              pg8::Gemm g{WSP(bf16, WS_YHY), WSP(bf16, WS_WHB) + (size_t)l * DM * DH, DH, DH}; pg8::StaticOrder S{NT / 256, DM / 256, G, vb}; pg8::EpiGate<false> E{PROJ + O_G, DIN, PROJ, DIN};
              pg8::gemm_phase<pg8::EpiGate<false>, pg8::StaticOrder, MK_GEMM_ALIGN, MK_GEMM_SP2>(lds, g, S, E, wv); }
            asm volatile("s_waitcnt vmcnt(0)" ::: "memory"); __syncthreads();
            { KP p = KARGS(); unsigned char* ws = p->ws; bf16* PROJ = WSP(bf16, WS_PROJ);
              pg8::Gemm g{PROJ + O_Q, WSP(bf16, WS_WAB) + (size_t)l * DM * DA, DIN, DA}; pg8::StaticOrder S{NT / 256, DM / 256, G, vb}; pg8::EpiGate<true> E{PROJ + O_G + DM, DIN, PROJ, DIN, MK_WO_F8 ? ws + WS_WIN : nullptr};
              pg8::gemm_phase<pg8::EpiGate<true>, pg8::StaticOrder, MK_GEMM_ALIGN, MK_GEMM_SP2>(lds, g, S, E, wv); }
#endif
        }
        SEAM(base + 4);
        if (IN(base + 5)) {
            KP p = KARGS(); unsigned char* ws = p->ws;
#if MK_WO_I8
            pg8::Gemm g{ws + WS_M8, ws + WS_WO + (size_t)l * DM * DM, DM, DM};
#elif MK_WO_F8
            pg8::Gemm g{ws + WS_WIN, ws + WS_WO + (size_t)l * DM * DM, DM, DM};
#else
            pg8::Gemm g{WSP(bf16, WS_PROJ), WSP(bf16, WS_WO) + (size_t)l * DM * DM, DIN, DM};
#endif
            pg8::StaticOrder S{NT / 256, DM / 256, G, vb}; float al_ = ALPHA; asm volatile("" : "+s"(al_));
#if MK_LN_FUSE
            {
                pg8::EpiResLn E{WSP(bf16, WS_H0), WSP(bf16, WS_H1), (l || MK_DENSE_I8) ? ws + WS_HF8 : nullptr, p->in[18] + l * DM, p->in[19] + l * DM, MK_WO_I8 ? i8_range_w(p, 3) * (1.0f / 127.0f) : (MK_WO_F8 ? 1.0f / 64.0f : 1.0f), al_, WSP(unsigned long long, WS_XBUF) + (size_t)l * 2 * NT * 8, WSP(unsigned, WS_CTL) + CW_PANEL + l * 2 * 8192, WSP(unsigned, WS_CTL) + CW_TMO, (l == 0 ? MK_DENSE_I8 : MK_I8_MOE) ? 127.0f / i8_range_a(p, l ? 3 : 1) : 0.f, MK_WO_I8 ? WSP(float, WS_XBUF + 12 * MiB) : nullptr};
                pg8::PanelOrder SP{NT / 256, G, vb};
                pg8::gemm_phase<pg8::EpiResLn, pg8::PanelOrder, true, MK_GEMM_SP2, (MK_WO_F8 || MK_WO_I8) ? 1 : 2, MK_WO_I8 != 0>(lds, g, SP, E, wv);
            }
#else
            { pg8::EpiRes E{WSP(bf16, WS_H0), p->out, 1.0f, al_};
              pg8::gemm_phase<pg8::EpiRes, pg8::StaticOrder, MK_GEMM_ALIGN, MK_GEMM_SP2>(lds, g, S, E, wv); }
#endif
        }
        SEAM(base + 5);
        if (l == 0) {
#if !MK_LN_FUSE
            if (IN(base + 6)) { KP p = KARGS(); ph_ln<false>(p, p->in[18], p->in[19], (bf16*)(p->ws + WS_H1), lds, vb, G, wv); }
            SEAM(base + 6);
#endif
            if (IN(base + 7)) {
                KP p = KARGS(); unsigned char* ws = p->ws;
#if MK_DENSE_I8
                const float s8 = (i8_range_a(p, 1) * (1.0f / 127.0f)) * (i8_range_w(p, 0) * (1.0f / 127.0f));
                pg8::Gemm g{ws + WS_HF8, ws + WS_WGU, DM, DM}; pg8::StaticOrder S{NT / 256, 2 * FF / 256, G, vb}; pg8::EpiSwigluF8 E{ws + WS_G, FF, s8};
                pg8::gemm_phase<pg8::EpiSwigluF8, pg8::StaticOrder, MK_GEMM_ALIGN, MK_GEMM_SP2, 1, true>(lds, g, S, E, wv);
#elif MK_DENSE_F8
                pg8::Gemm g{ws + WS_HF8, ws + WS_WGU, DM, DM}; pg8::StaticOrder S{NT / 256, 2 * FF / 256, G, vb}; pg8::EpiSwigluF8 E{ws + WS_G, FF, 1.0f / SC_GU};
                pg8::gemm_phase<pg8::EpiSwigluF8, pg8::StaticOrder, MK_GEMM_ALIGN, MK_GEMM_SP2, 1>(lds, g, S, E, wv);
#elif MK_DENSE_DN_F8
                pg8::Gemm g{WSP(bf16, WS_H1), WSP(bf16, WS_WGU), DM, DM}; pg8::StaticOrder S{NT / 256, 2 * FF / 256, G, vb}; pg8::EpiSwigluF8 E{ws + WS_G, FF, 1.0f};
                pg8::gemm_phase<pg8::EpiSwigluF8, pg8::StaticOrder, MK_GEMM_ALIGN, MK_GEMM_SP2>(lds, g, S, E, wv);
#else
                pg8::Gemm g{WSP(bf16, WS_H1), WSP(bf16, WS_WGU), DM, DM}; pg8::StaticOrder S{NT / 256, 2 * FF / 256, G, vb}; pg8::EpiSwiglu E{WSP(bf16, WS_G), FF};
                pg8::gemm_phase<pg8::EpiSwiglu, pg8::StaticOrder, MK_GEMM_ALIGN, MK_GEMM_SP2>(lds, g, S, E, wv);
#endif
            }
            SEAM(base + 7);
            if (IN(base + 8)) {
                KP p = KARGS(); unsigned char* ws = p->ws;
                pg8::Gemm g{ws + WS_G, ws + WS_WD, FF, FF}; pg8::StaticOrder S{NT / 256, DM / 256, G, vb}; float al_ = ALPHA; asm volatile("" : "+s"(al_));
#if MK_LN_FUSE
                pg8::EpiResLn E{WSP(bf16, WS_H1), WSP(bf16, WS_H0), ws + WS_HF8, p->in[28], p->in[29], (MK_DENSE_F8 || MK_DENSE_DN_F8) ? 1.0f / SC_DN : 1.0f, al_, WSP(unsigned long long, WS_XBUF) + (size_t)NT * 8, WSP(unsigned, WS_CTL) + CW_PANEL + 8192, WSP(unsigned, WS_CTL) + CW_TMO, MK_I8_GATES ? 127.0f / i8_range_a(p, 2) : 0.f};
                pg8::PanelOrder SP{NT / 256, G, vb};
                pg8::gemm_phase<pg8::EpiResLn, pg8::PanelOrder, true, MK_GEMM_SP2, (MK_DENSE_F8 || MK_DENSE_DN_F8) ? 1 : 2>(lds, g, SP, E, wv);
#else
                pg8::EpiRes E{WSP(bf16, WS_H1), p->out, (MK_DENSE_F8 || MK_DENSE_DN_F8) ? 1.0f / SC_DN : 1.0f, al_};
                pg8::gemm_phase<pg8::EpiRes, pg8::StaticOrder, MK_GEMM_ALIGN, MK_GEMM_SP2, (MK_DENSE_F8 || MK_DENSE_DN_F8) ? 1 : 2>(lds, g, S, E, wv);
#endif
            }
#if MK_LN_FUSE
            if (lo <= base + 8 && base + 20 < hi) xcd_barrier(bar, wv);
#else
            SEAM(base + 8);
            if (IN(base + 9)) { KP p = KARGS(); ph_ln<false>(p, p->in[28], p->in[29], (bf16*)(p->ws + WS_H0), lds, vb, G, wv); }
            if (lo <= base + 9 && base + 20 < hi) xcd_barrier(bar, wv);
#endif
        } else {
#if MK_LN_FUSE
            if (IN(base + 6)) { KP p = KARGS(); ph_router(p, lds, vb, G, wv); }
#else
            if (IN(base + 6)) { KP p = KARGS(); ph_ln<true>(p, p->in[18] + DM, p->in[19] + DM, (bf16*)(p->ws + WS_H1), lds, vb, G, wv); }
#endif
            SEAM(base + 6);
            if (IN(base + 7)) { KP p = KARGS(); ph_gather(p, vb, G, wv); }
            SEAM(base + 7);
            for (int c = 0; c < 1; ++c) {
                int ntl, tile0;
                { KP p = KARGS(); const int ntiles = (int)__hip_atomic_load((unsigned*)(p->ws + WS_CTL) + CW_NTILES, __ATOMIC_RELAXED, __HIP_MEMORY_SCOPE_AGENT);
                  tile0 = c * CHUNK_TILES; ntl = ntiles - tile0; ntl = ntl < 0 ? 0 : (ntl > CHUNK_TILES ? CHUNK_TILES : ntl); }
                if (IN(base + 8 + 2 * c) && ntl > 0) {
                    KP p = KARGS(); unsigned char* ws = p->ws;
                    pg8::Gemm g{ws + WS_XG, ws + WS_EGU, DM, DM}; pg8::GroupedOrder S{ntl, tile0, 2 * FE / 256, G, vb, WSP(unsigned, WS_CTL) + CW_TILE_E, false}; pg8::EpiSwigluF8 E{ws + WS_HM, FE, MK_I8_MOE ? (i8_range_a(p, 3) * (1.0f / 127.0f)) * (i8_range_w(p, 2) * (1.0f / 127.0f)) : 1.0f / SC_GU};
                    pg8::gemm_phase<pg8::EpiSwigluF8, pg8::GroupedOrder, MK_GEMM_ALIGN, MK_GEMM_SP2, 1, MK_I8_MOE != 0>(lds, g, S, E, wv);
                }
                SEAM(base + 8 + 2 * c);
                if (IN(base + 9 + 2 * c) && ntl > 0) {
                    KP p = KARGS(); unsigned char* ws = p->ws;
                    pg8::Gemm g{ws + WS_HM, ws + WS_ED, FE, FE}; pg8::GroupedOrder S{ntl, tile0, DM / 256, G, vb, WSP(unsigned, WS_CTL) + CW_TILE_E, true}; pg8::EpiStoreScaled E{WSP(bf16, WS_YG), DM, 1.0f / SC_DN};
                    pg8::gemm_phase<pg8::EpiStoreScaled, pg8::GroupedOrder, MK_GEMM_ALIGN, MK_GEMM_SP2, 1>(lds, g, S, E, wv);
                }
                SEAM(base + 9 + 2 * c);
            }
            if (IN(base + 18)) { KP p = KARGS(); ph_combine_ln(p, p->in[28] + DM, p->in[29] + DM, vb, G, wv); }
        }
    }
#undef IN
#undef SEAM
}

#ifndef MK_SPLIT
#define MK_SPLIT 0
#endif
extern "C" void kernel_launch(void* const* d_in, const int* in_sizes, int n_in, void* d_out, int out_size, void* d_ws, size_t ws_size, hipStream_t stream) {
    static int ready = 0;
    if (ready == 0) {
        if (n_in != 30 || out_size != NT * DM || ws_size < WS_END) { fprintf(stderr, "kernel_launch: unexpected shapes (n_in %d out %d ws %zu need %zu)\n", n_in, out_size, ws_size, (size_t)WS_END); ready = -1; return; }
        if (hipFuncSetAttribute((const void*)k_mega, hipFuncAttributeMaxDynamicSharedMemorySize, LDS_BYTES) != hipSuccess) { fprintf(stderr, "kernel_launch: hipFuncSetAttribute failed\n"); ready = -1; return; }
        ready = 1;
    }
    if (ready < 0) return;
    unsigned char* ws = (unsigned char*)d_ws;
    (void)hipMemsetAsync(ws + WS_CTL, 0, 1 * MiB, stream);
    Params p; memset(&p, 0, sizeof(p));
    for (int i = 0; i < 30; ++i) p.in[i] = (const float*)d_in[i];
    p.out = (float*)d_out; p.ws = ws;
#if MK_SPLIT
    for (int ph = 0; ph < N_PHASES; ++ph) {
        const int k = ph == 0 ? -1 : (ph - 1) % 20, l = ph == 0 ? 0 : (ph - 1) / 20;
        if (l == 0 && k >= 10) continue;
        if (l == 1 && k == 19) continue;
        p.ph_lo = ph; p.ph_hi = ph + 1;
        hipLaunchKernelGGL(k_mega, dim3(256), dim3(512), LDS_BYTES, stream, p);
    }
#else
    p.ph_lo = 0; p.ph_hi = N_PHASES;
    hipLaunchKernelGGL(k_mega, dim3(256), dim3(512), LDS_BYTES, stream, p);
#endif
}
```
